# Optimizing an MI355X kernel written in HIP

```python
import math
import jax, jax.numpy as jnp
from jax import lax
import numpy as np

D_MODEL = 2048
BATCH = 8
SEQ = 2048
DEPTH = 2

CTX_LEN = 256
GRID_W = 64
HEAD_DIM = 128
N_HEADS = D_MODEL // HEAD_DIM
BRANCH_W = N_HEADS * HEAD_DIM
MLA_HEADS = N_HEADS
MLA_NOPE = 128
MLA_ROPE = 64
MLA_V = 128
KV_RANK = D_MODEL // 4
NA_HEADS = N_HEADS
NA_DIM = HEAD_DIM
NA_KR_MAX = 8
NA_KC = 16
GQA_HEADS = N_HEADS
GQA_KV_HEADS = N_HEADS // 4
GQA_GROUP = GQA_HEADS // GQA_KV_HEADS
GQA_DIM = HEAD_DIM
D_FF = 256 * ((8 * D_MODEL // 3 + 255) // 256)
CONV_W = 3
Q_BLOCK = 128
ROPE_THETA = 10000.0
ADA_EPS = 1e-6
POST_EPS = 1e-5
RMS_EPS = 1e-6
NEG_INF = -1e30
ALPHA = (2 * DEPTH) ** 0.25
BETA = (8 * DEPTH) ** -0.25
MLA_SCALE = (MLA_NOPE + MLA_ROPE) ** -0.5
NA_SCALE = NA_DIM ** -0.5
GQA_SCALE = GQA_DIM ** -0.5
SPLITS = (MLA_HEADS * (MLA_NOPE + MLA_ROPE),
          KV_RANK,
          MLA_ROPE,
          3 * NA_HEADS * NA_DIM,
          GQA_HEADS * GQA_DIM,
          2 * GQA_KV_HEADS * GQA_DIM,
          3 * D_MODEL)
SPLIT_IDX = tuple(int(v) for v in np.cumsum(SPLITS)[:-1])
N_IN = int(sum(SPLITS))

kernel_name = "hybrid_mla_na_gqa_convffn_deepnorm_dit"


def _layernorm(x, eps, g=None, b=None):
    xf = x.astype(jnp.float32)
    mu = jnp.mean(xf, -1, keepdims=True)
    var = jnp.mean(jnp.square(xf - mu), -1, keepdims=True)
    y = (xf - mu) * lax.rsqrt(var + eps)
    if g is not None:
        y = y * g.astype(jnp.float32) + b.astype(jnp.float32)
    return y.astype(x.dtype)


def _rmsnorm(x, g):
    xf = x.astype(jnp.float32)
    y = xf * lax.rsqrt(jnp.mean(xf * xf, -1, keepdims=True) + RMS_EPS) * g.astype(jnp.float32)
    return y.astype(x.dtype)


def _rope_1d(x, pos):
    half = x.shape[-1] // 2
    freqs = ROPE_THETA ** (-jnp.arange(half, dtype=jnp.float32) / half)
    ang = pos.astype(jnp.float32)[:, None] * freqs[None, :]
    cos = jnp.cos(ang)[None, :, None, :]
    sin = jnp.sin(ang)[None, :, None, :]
    xf = x.astype(jnp.float32)
    x1, x2 = xf[..., :half], xf[..., half:]
    return jnp.concatenate([x1 * cos - x2 * sin, x1 * sin + x2 * cos], -1).astype(x.dtype)


def _rope_2d(x, rows, cols):
    half = x.shape[-1] // 2
    return jnp.concatenate([_rope_1d(x[..., :half], rows), _rope_1d(x[..., half:], cols)], -1)


def _sdpa(q, k, v, scale):
    s = jnp.einsum('bqhgd,bkhd->bhgqk', q, k).astype(jnp.float32) * scale
    p = jax.nn.softmax(s, axis=-1).astype(v.dtype)
    return jnp.einsum('bhgqk,bkhe->bqhge', p, v)


def _blocked_sdpa(q, k, v, scale):
    B, S = q.shape[:2]
    nb = S // Q_BLOCK
    qb = jnp.moveaxis(q.reshape(B, nb, Q_BLOCK, *q.shape[2:]), 1, 0)
    out = lax.map(lambda qi: _sdpa(qi, k, v, scale), qb)
    return jnp.moveaxis(out, 0, 1).reshape(B, S, *out.shape[3:])


def _mla_query(mq, rows, cols):
    B, T = mq.shape[:2]
    q = mq.reshape(B, T, MLA_HEADS, MLA_NOPE + MLA_ROPE)
    if rows is not None:
        q = jnp.concatenate([q[..., :MLA_NOPE], _rope_2d(q[..., MLA_NOPE:], rows, cols)], -1)
    return q[:, :, :, None, :]


def _mla_kv(ckv, kr, kv_norm, w_ukv, rows, cols):
    B, T = ckv.shape[:2]
    c = _rmsnorm(ckv, kv_norm)
    kv = jnp.einsum('btr,rf->btf', c, w_ukv).reshape(B, T, MLA_HEADS, MLA_NOPE + MLA_V)
    k_nope, v = kv[..., :MLA_NOPE], kv[..., MLA_NOPE:]
    k_rope = kr[:, :, None, :]
    if rows is not None:
        k_rope = _rope_2d(k_rope, rows, cols)
    k = jnp.concatenate([k_nope, jnp.broadcast_to(k_rope, (B, T, MLA_HEADS, MLA_ROPE))], -1)
    return k, v


def _gqa_qkv(gq, gkv, q_norm, k_norm, rows, cols):
    B, T = gq.shape[:2]
    q = _rmsnorm(gq.reshape(B, T, GQA_HEADS, GQA_DIM), q_norm)
    kv = gkv.reshape(B, T, 2, GQA_KV_HEADS, GQA_DIM)
    k = _rmsnorm(kv[:, :, 0], k_norm)
    v = kv[:, :, 1]
    if rows is not None:
        q = _rope_2d(q, rows, cols)
        k = _rope_2d(k, rows, cols)
    return q.reshape(B, T, GQA_KV_HEADS, GQA_GROUP, GQA_DIM), k, v


def _na_latent(q, k, v, k_ctx, v_ctx, rpb):
    B, S, H, d = q.shape
    rows_n = S // GRID_W
    kr = min(NA_KR_MAX, rows_n)
    qg = q.reshape(B, rows_n, GRID_W, H, d)
    kg = k.reshape(B, rows_n, GRID_W, H, d)
    vg = v.reshape(B, rows_n, GRID_W, H, d)
    col = jnp.arange(GRID_W)
    cs = jnp.clip(col - NA_KC // 2, 0, GRID_W - NA_KC)
    col_valid = (col[None, :] >= cs[:, None]) & (col[None, :] < cs[:, None] + NA_KC)
    mask = jnp.broadcast_to(col_valid[:, None, :], (GRID_W, kr, GRID_W)).reshape(GRID_W, kr * GRID_W)
    dc_idx = jnp.clip(col[None, :] - col[:, None] + NA_KC - 1, 0, 2 * NA_KC - 2)
    n_lat = kr * GRID_W

    def row(r):
        rs = jnp.clip(r - kr // 2, 0, rows_n - kr)
        q_r = lax.dynamic_index_in_dim(qg, r, axis=1, keepdims=False)
        k_r = lax.dynamic_slice_in_dim(kg, rs, kr, axis=1).reshape(B, n_lat, H, d)
        v_r = lax.dynamic_slice_in_dim(vg, rs, kr, axis=1).reshape(B, n_lat, H, d)
        dr_idx = rs + jnp.arange(kr) - r + NA_KR_MAX - 1
        bias = jnp.take(rpb[:, dr_idx], dc_idx, axis=2)
        bias = jnp.transpose(bias, (0, 2, 1, 3)).reshape(H, GRID_W, n_lat).astype(jnp.float32)
        s_lat = jnp.einsum('bqhd,bkhd->bhqk', q_r, k_r).astype(jnp.float32) * NA_SCALE + bias
        s_lat = jnp.where(mask, s_lat, NEG_INF)
        s_ctx = jnp.einsum('bqhd,bkhd->bhqk', q_r, k_ctx).astype(jnp.float32) * NA_SCALE
        p = jax.nn.softmax(jnp.concatenate([s_lat, s_ctx], -1), axis=-1).astype(v.dtype)
        return (jnp.einsum('bhqk,bkhd->bqhd', p[..., :n_lat], v_r)
                + jnp.einsum('bhqk,bkhd->bqhd', p[..., n_lat:], v_ctx))

    out = lax.map(row, jnp.arange(rows_n))
    return jnp.moveaxis(out, 0, 1).reshape(B, S, H, d)


def _merge(ys, gates, w_branch, w_out):
    gs = jnp.split(gates, 3, axis=-1)
    acc = sum(jax.nn.sigmoid(g) * (y @ w_branch[i]) for i, (y, g) in enumerate(zip(ys, gs)))
    return acc @ w_out


def _token_mixers(h_lat, h_ctx, lp, rows, cols, with_ctx):
    B, S, _ = h_lat.shape
    L = h_ctx.shape[1]
    p_lat = h_lat @ lp['w_in']
    p_ctx = h_ctx @ lp['w_in']
    mq_l, ckv_l, kr_l, na_l, gq_l, gkv_l, gate_l = jnp.split(p_lat, SPLIT_IDX, axis=-1)
    mq_c, ckv_c, kr_c, na_c, gq_c, gkv_c, gate_c = jnp.split(p_ctx, SPLIT_IDX, axis=-1)

    qa_l = _mla_query(mq_l, rows, cols)
    ka_l, va_l = _mla_kv(ckv_l, kr_l, lp['mla_kv_norm'], lp['w_mla_ukv'], rows, cols)
    ka_c, va_c = _mla_kv(ckv_c, kr_c, lp['mla_kv_norm'], lp['w_mla_ukv'], None, None)
    ya_l = _blocked_sdpa(qa_l, jnp.concatenate([ka_l, ka_c], 1), jnp.concatenate([va_l, va_c], 1),
                         MLA_SCALE).reshape(B, S, BRANCH_W)

    qkv_l = na_l.reshape(B, S, 3, NA_HEADS, NA_DIM)
    qkv_c = na_c.reshape(B, L, 3, NA_HEADS, NA_DIM)
    yb_l = _na_latent(qkv_l[:, :, 0], qkv_l[:, :, 1], qkv_l[:, :, 2],
                      qkv_c[:, :, 1], qkv_c[:, :, 2], lp['na_rpb']).reshape(B, S, BRANCH_W)

    qc_l, kc_l, vc_l = _gqa_qkv(gq_l, gkv_l, lp['gqa_q_norm'], lp['gqa_k_norm'], rows, cols)
    qc_c, kc_c, vc_c = _gqa_qkv(gq_c, gkv_c, lp['gqa_q_norm'], lp['gqa_k_norm'], None, None)
    yc_l = _blocked_sdpa(qc_l, jnp.concatenate([kc_l, kc_c], 1), jnp.concatenate([vc_l, vc_c], 1),
                         GQA_SCALE).reshape(B, S, BRANCH_W)

    y_lat = _merge((ya_l, yb_l, yc_l), gate_l, lp['w_branch'], lp['w_out'])
    if not with_ctx:
        return y_lat, None
    ya_c = _sdpa(_mla_query(mq_c, None, None), ka_c, va_c, MLA_SCALE).reshape(B, L, BRANCH_W)
    yb_c = _sdpa(qkv_c[:, :, 0][:, :, :, None, :], qkv_c[:, :, 1], qkv_c[:, :, 2],
                 NA_SCALE).reshape(B, L, BRANCH_W)
    yc_c = _sdpa(qc_c, kc_c, vc_c, GQA_SCALE).reshape(B, L, BRANCH_W)
    y_ctx = _merge((ya_c, yb_c, yc_c), gate_c, lp['w_branch'], lp['w_out'])
    return y_lat, y_ctx


def _conv_ffn(h, w_up, conv_w, conv_b, w_down):
    u = h @ w_up
    gate, val = u[..., :D_FF], u[..., D_FF:]
    gp = jnp.pad(gate, ((0, 0), (1, 1), (0, 0)))
    gate = gp[:, :-2] * conv_w[0] + gp[:, 1:-1] * conv_w[1] + gp[:, 2:] * conv_w[2] + conv_b
    return (jax.nn.silu(gate) * val) @ w_down


def _modulate(x, shift, scale):
    return _layernorm(x, ADA_EPS) * (1 + scale) + shift


def setup_inputs(seed: int = 0) -> dict:
    key = jax.random.key(seed)
    ks = jax.random.split(key, 24)
    f32 = jnp.float32

    def nrm(k, shape, scale):
        return jax.random.normal(k, shape, f32) * scale

    L = DEPTH
    return {
        'x': nrm(ks[0], (BATCH, SEQ, D_MODEL), 1.0),
        'c': nrm(ks[1], (BATCH, D_MODEL), 1.0),
        'ctx': nrm(ks[2], (BATCH, CTX_LEN, D_MODEL), 1.0),
        'c_ctx': nrm(ks[3], (D_MODEL,), 1.0),
        'w_ada': nrm(ks[4], (L, D_MODEL, 6 * D_MODEL), 0.5 * D_MODEL ** -0.5),
        'b_ada': nrm(ks[5], (L, 6 * D_MODEL), 0.02),
        'w_in': nrm(ks[6], (L, D_MODEL, N_IN), D_MODEL ** -0.5),
        'mla_kv_norm': 1.0 + nrm(ks[7], (L, KV_RANK), 0.1),
        'w_mla_ukv': nrm(ks[8], (L, KV_RANK, MLA_HEADS * (MLA_NOPE + MLA_V)), KV_RANK ** -0.5),
        'gqa_q_norm': 1.0 + nrm(ks[9], (L, GQA_DIM), 0.1),
        'gqa_k_norm': 1.0 + nrm(ks[10], (L, GQA_DIM), 0.1),
        'na_rpb': nrm(ks[11], (L, NA_HEADS, 2 * NA_KR_MAX - 1, 2 * NA_KC - 1), 0.05),
        'w_branch': nrm(ks[12], (L, 3, BRANCH_W, D_MODEL), BETA * BRANCH_W ** -0.5),
        'w_out': nrm(ks[13], (L, D_MODEL, D_MODEL), BETA * D_MODEL ** -0.5),
        'ln_a_g': 1.0 + nrm(ks[14], (L, D_MODEL), 0.1),
        'ln_a_b': nrm(ks[15], (L, D_MODEL), 0.02),
        'w_up': nrm(ks[16], (L, D_MODEL, 2 * D_FF), D_MODEL ** -0.5),
        'conv_w': nrm(ks[17], (L, CONV_W, D_FF), CONV_W ** -0.5),
        'conv_b': nrm(ks[18], (L, D_FF), 0.02),
        'w_down': nrm(ks[19], (L, D_FF, D_MODEL), BETA * D_FF ** -0.5),
        'ln_f_g': 1.0 + nrm(ks[20], (L, D_MODEL), 0.1),
        'ln_f_b': nrm(ks[21], (L, D_MODEL), 0.02),
    }


def reference(x, c, ctx, c_ctx, w_ada, b_ada, w_in, mla_kv_norm, w_mla_ukv, gqa_q_norm, gqa_k_norm,
              na_rpb, w_branch, w_out, ln_a_g, ln_a_b, w_up, conv_w, conv_b, w_down, ln_f_g, ln_f_b):
    S = x.shape[1]
    t = jnp.arange(S)
    rows, cols = t // GRID_W, t % GRID_W
    x_lat, x_ctx = x, ctx
    for l in range(DEPTH):
        with_ctx = l < DEPTH - 1
        lp = {'w_in': w_in[l], 'mla_kv_norm': mla_kv_norm[l], 'w_mla_ukv': w_mla_ukv[l],
              'gqa_q_norm': gqa_q_norm[l], 'gqa_k_norm': gqa_k_norm[l], 'na_rpb': na_rpb[l],
              'w_branch': w_branch[l], 'w_out': w_out[l]}
        m_lat = (jax.nn.silu(c) @ w_ada[l] + b_ada[l]).reshape(c.shape[0], 1, 6, D_MODEL)
        m_ctx = (jax.nn.silu(c_ctx) @ w_ada[l] + b_ada[l]).reshape(1, 1, 6, D_MODEL)
        h_lat = _modulate(x_lat, m_lat[..., 0, :], m_lat[..., 1, :])
        h_ctx = _modulate(x_ctx, m_ctx[..., 0, :], m_ctx[..., 1, :])
        y_lat, y_ctx = _token_mixers(h_lat, h_ctx, lp, rows, cols, with_ctx)
        x_lat = _layernorm(ALPHA * x_lat + m_lat[..., 2, :] * y_lat, POST_EPS, ln_a_g[l], ln_a_b[l])
        h_lat = _modulate(x_lat, m_lat[..., 3, :], m_lat[..., 4, :])
        f_lat = _conv_ffn(h_lat, w_up[l], conv_w[l], conv_b[l], w_down[l])
        x_lat = _layernorm(ALPHA * x_lat + m_lat[..., 5, :] * f_lat, POST_EPS, ln_f_g[l], ln_f_b[l])
        if with_ctx:
            x_ctx = _layernorm(ALPHA * x_ctx + m_ctx[..., 2, :] * y_ctx, POST_EPS, ln_a_g[l], ln_a_b[l])
            h_ctx = _modulate(x_ctx, m_ctx[..., 3, :], m_ctx[..., 4, :])
            f_ctx = _conv_ffn(h_ctx, w_up[l], conv_w[l], conv_b[l], w_down[l])
            x_ctx = _layernorm(ALPHA * x_ctx + m_ctx[..., 5, :] * f_ctx, POST_EPS, ln_f_g[l], ln_f_b[l])
    return x_lat
```

```cpp
#include <hip/hip_runtime.h>
#include <cstdio>
#include <cstdint>
namespace pg8 {
#define PG8_LAS __attribute__((address_space(3)))
typedef unsigned short bf16_t;
typedef short bf16x8 __attribute__((ext_vector_type(8)));
typedef float f32x4 __attribute__((ext_vector_type(4)));
typedef unsigned u32x4 __attribute__((ext_vector_type(4)));
constexpr int BM = 256, BK = 64, HALF = 128, HTB = HALF * BK * 2, STAGE_BYTES = 8 * HTB, NXCD = 8, WGM = 8;

__host__ __device__ __forceinline__ int lds_byte(int r, int c) { const int st = (r >> 4) * 2 + (c >> 5), rr = r & 15, cc = c & 31, ob = rr * 64 + cc * 2; return st * 1024 + (ob ^ (((ob >> 9) & 1) << 5)); }
__host__ __device__ __forceinline__ void stage_rc(int b, int& R, int& C) { const int st = b / 1024, sb = b % 1024, swz = sb ^ (((sb >> 9) & 1) << 5); R = (st >> 1) * 16 + swz / 64; C = (st & 1) * 32 + (swz % 64) / 2; }
__host__ __device__ __forceinline__ int perm32(int rho) { const int n = rho >> 4, i = rho & 15; return 8 * (i >> 2) + 4 * n + (i & 3); }

struct Unit { int pm, pn, z; };
struct Gemm { const bf16_t* A; const bf16_t* Bt; int lda, K, kstepA; };

struct StaticOrder {
    int nM, nN, nwg, G, c, skip9, nz;
    __device__ void init(int nM_, int nN_, int G_, int c_, int skip9_, int nz_) { nM = nM_; nN = nN_; nwg = nM * nN; G = G_; c = c_; skip9 = skip9_; nz = nz_; }
    __device__ bool next(int i, Unit& u) const {
        const int it = i / nz; u.z = i - it * nz;
        const long L = (long)it * G + c; if (L >= nwg) return false;
        int wgid = (int)L; { const int q = nwg / NXCD, r = nwg % NXCD, xcd = wgid % NXCD, off = wgid / NXCD; wgid = (xcd < r ? xcd * (q + 1) : r * (q + 1) + (xcd - r) * q) + off; }
        const int nig = WGM * nN, gid = wgid / nig, fm = gid * WGM, gsz = (nM - fm) < WGM ? (nM - fm) : WGM;
        int pm = fm + ((wgid % nig) % gsz); u.pn = (wgid % nig) / gsz;
        if (skip9) pm += pm >> 3;
        u.pm = pm; return true;
    }
};

__device__ __forceinline__ unsigned cvt_pk_bf16(float lo, float hi) { unsigned r; asm volatile("v_cvt_pk_bf16_f32 %0, %1, %2" : "=v"(r) : "v"(lo), "v"(hi)); return r; }

struct EpiF32 {
    static constexpr bool PERM = false; static constexpr int NST = 16;
    float* C; int ldc; float scale;
    __device__ __forceinline__ size_t aoff(const Unit& u, int lda) const { return (size_t)u.pm * BM * lda * 2; }
    __device__ __forceinline__ size_t boff(const Unit& u, int K) const { return (size_t)u.pn * BM * K * 2; }
    __device__ __forceinline__ void operator()(const f32x4 (&acc)[2][2][4][2], const Unit& u, int wr, int wc, int fr, int fq) const {
        const int row0 = u.pm * BM + wr * 64 + fr, col0 = u.pn * BM + wc * 32 + 4 * fq;
#pragma unroll
        for (int ai = 0; ai < 2; ++ai)
#pragma unroll
            for (int m = 0; m < 4; ++m) { float* rowp = C + (size_t)(row0 + ai * HALF + m * 16) * ldc + col0;
#pragma unroll
                for (int bj = 0; bj < 2; ++bj)
#pragma unroll
                    for (int n = 0; n < 2; ++n) *(f32x4*)(rowp + bj * HALF + n * 16) = acc[ai][bj][m][n] * scale; }
    }
};
struct EpiBf16 {
    static constexpr bool PERM = true; static constexpr int NST = 16;
    bf16_t* O; int ldc; float scale;
    __device__ __forceinline__ size_t aoff(const Unit& u, int lda) const { return (size_t)u.pm * BM * lda * 2; }
    __device__ __forceinline__ size_t boff(const Unit& u, int K) const { return (size_t)u.pn * BM * K * 2; }
    __device__ __forceinline__ void operator()(const f32x4 (&acc)[2][2][4][2], const Unit& u, int wr, int wc, int fr, int fq) const {
        const int row0 = u.pm * BM + wr * 64 + fr, col0 = u.pn * BM + wc * 32 + 8 * fq;
#pragma unroll
        for (int ai = 0; ai < 2; ++ai)
#pragma unroll
            for (int m = 0; m < 4; ++m) { bf16_t* rowp = O + (size_t)(row0 + ai * HALF + m * 16) * ldc + col0;
#pragma unroll
                for (int bj = 0; bj < 2; ++bj) { const f32x4 v0 = acc[ai][bj][m][0] * scale, v1 = acc[ai][bj][m][1] * scale;
                    u32x4 w; w.x = cvt_pk_bf16(v0[0], v0[1]); w.y = cvt_pk_bf16(v0[2], v0[3]); w.z = cvt_pk_bf16(v1[0], v1[1]); w.w = cvt_pk_bf16(v1[2], v1[3]);
                    *(u32x4*)(rowp + bj * HALF) = w; } }
    }
};
struct EpiKV {
    static constexpr bool PERM = true; static constexpr int NST = 16;
    unsigned char* K8; unsigned char* V8; float scale;
    __device__ __forceinline__ size_t aoff(const Unit& u, int lda) const { return (size_t)u.pm * BM * lda * 2; }
    __device__ __forceinline__ size_t boff(const Unit& u, int K) const { return (size_t)u.pn * BM * K * 2; }
    __device__ __forceinline__ void operator()(const f32x4 (&acc)[2][2][4][2], const Unit& u, int wr, int wc, int fr, int fq) const {
        const int row0 = u.pm * BM + wr * 64 + fr, col0 = u.pn * 128 + wc * 32 + 8 * fq;
        typedef unsigned u32x2 __attribute__((ext_vector_type(2)));
#pragma unroll
        for (int ai = 0; ai < 2; ++ai)
#pragma unroll
            for (int m = 0; m < 4; ++m) { const size_t row = (size_t)(row0 + ai * HALF + m * 16);
                { const f32x4 v0 = acc[ai][0][m][0] * scale, v1 = acc[ai][0][m][1] * scale; int w0 = 0, w1 = 0;
                  w0 = __builtin_amdgcn_cvt_pk_fp8_f32(v0[0], v0[1], w0, false); w0 = __builtin_amdgcn_cvt_pk_fp8_f32(v0[2], v0[3], w0, true);
                  w1 = __builtin_amdgcn_cvt_pk_fp8_f32(v1[0], v1[1], w1, false); w1 = __builtin_amdgcn_cvt_pk_fp8_f32(v1[2], v1[3], w1, true);
                  *(u32x2*)(K8 + row * 2048 + col0) = (u32x2){(unsigned)w0, (unsigned)w1}; }
                { const f32x4 v0 = acc[ai][1][m][0] * scale, v1 = acc[ai][1][m][1] * scale; int w0 = 0, w1 = 0;
                  w0 = __builtin_amdgcn_cvt_pk_fp8_f32(v0[0], v0[1], w0, false); w0 = __builtin_amdgcn_cvt_pk_fp8_f32(v0[2], v0[3], w0, true);
                  w1 = __builtin_amdgcn_cvt_pk_fp8_f32(v1[0], v1[1], w1, false); w1 = __builtin_amdgcn_cvt_pk_fp8_f32(v1[2], v1[3], w1, true);
                  *(u32x2*)(V8 + row * 2048 + col0) = (u32x2){(unsigned)w0, (unsigned)w1}; } }
    }
};
struct EpiWin {
    static constexpr bool PERM = true; static constexpr int NST = 8;
    bf16_t* O; int ldc; float scale; unsigned char* base8; unsigned char* KN8; unsigned char* VN8; unsigned char* VG8; int c_nk, c_nv, c_gq, c_gv, c_gate, c_nq;
    __device__ __forceinline__ size_t aoff(const Unit& u, int lda) const { return (size_t)u.pm * BM * lda * 2; }
    __device__ __forceinline__ size_t boff(const Unit& u, int K) const { return (size_t)u.pn * BM * K * 2; }
    __device__ __forceinline__ void operator()(const f32x4 (&acc)[2][2][4][2], const Unit& u, int wr, int wc, int fr, int fq) const {
        const int row0 = u.pm * BM + wr * 64 + fr, col = u.pn * BM + wc * 64 + 8 * fq;
        const bool in_nk = (col >= c_nk) && (col < c_nv), in_nv = (col >= c_nv) && (col < c_gq), in_gv = (col >= c_gv) && (col < c_gate), in_gt = (col >= c_gate) && (col < c_gate + 6144), in_nq = (col >= c_nq) && (col < c_nk), is8 = in_nk || in_nv || in_gv || in_gt || in_nq;
        const float sc = in_gt ? scale * -1.4426950408889634f : scale;
        if (is8) {
            const size_t a8 = (in_nk ? (size_t)(KN8 - base8) + (size_t)(col - c_nk) : 0) + (in_nv ? (size_t)(VN8 - base8) + (size_t)(col - c_nv) : 0) + (in_gv ? (size_t)(VG8 - base8) + (size_t)(col - c_gv) : 0) + (in_gt ? (size_t)((unsigned char*)O - base8) + (size_t)c_gate * 2 + (size_t)(col - c_gate) : 0)
                + (in_nq ? (size_t)((unsigned char*)O - base8) + (size_t)c_nq * 2 + (size_t)(((col - c_nq) >> 7) * 256 + ((col - c_nq) & 127)) : 0);
            const int ld8 = in_gv ? 512 : ((in_gt || in_nq) ? ldc * 2 : 2048);
            unsigned char* dl = base8 + a8 + ((fq & 1) ? 24 : 0);
#pragma unroll
            for (int ai = 0; ai < 2; ++ai)
#pragma unroll
                for (int m = 0; m < 4; ++m) { const size_t row = (size_t)(row0 + ai * HALF + m * 16);
                    unsigned b0[2], b1[2];
#pragma unroll
                    for (int bj = 0; bj < 2; ++bj) { const f32x4 v0 = acc[ai][bj][m][0] * sc, v1 = acc[ai][bj][m][1] * sc; int w0 = 0, w1 = 0;
                        w0 = __builtin_amdgcn_cvt_pk_fp8_f32(v0[0], v0[1], w0, false); w0 = __builtin_amdgcn_cvt_pk_fp8_f32(v0[2], v0[3], w0, true);
                        w1 = __builtin_amdgcn_cvt_pk_fp8_f32(v1[0], v1[1], w1, false); w1 = __builtin_amdgcn_cvt_pk_fp8_f32(v1[2], v1[3], w1, true);
                        if (bj == 0) { b0[0] = (unsigned)w0; b0[1] = (unsigned)w1; } else { b1[0] = (unsigned)w0; b1[1] = (unsigned)w1; } }
                    { auto r = __builtin_amdgcn_permlane16_swap(b0[0], b1[0], false, false); b0[0] = r[0]; b1[0] = r[1]; }
                    { auto r = __builtin_amdgcn_permlane16_swap(b0[1], b1[1], false, false); b0[1] = r[0]; b1[1] = r[1]; }
                    *(u32x4*)(dl + row * ld8) = (u32x4){b0[0], b0[1], b1[0], b1[1]}; }
        } else {
            const int hi8 = fr >> 3; bf16_t* ob = O + col + 32 * hi8;
#pragma unroll
            for (int ai = 0; ai < 2; ++ai)
#pragma unroll
                for (int m = 0; m < 4; ++m) { const size_t row = (size_t)(row0 + ai * HALF + m * 16);
                    unsigned b0[4], b1[4], n0[4], n1[4];
                    { const f32x4 v0 = acc[ai][0][m][0] * sc, v1 = acc[ai][0][m][1] * sc; b0[0] = cvt_pk_bf16(v0[0], v0[1]); b0[1] = cvt_pk_bf16(v0[2], v0[3]); b0[2] = cvt_pk_bf16(v1[0], v1[1]); b0[3] = cvt_pk_bf16(v1[2], v1[3]); }
                    { const f32x4 v0 = acc[ai][1][m][0] * sc, v1 = acc[ai][1][m][1] * sc; b1[0] = cvt_pk_bf16(v0[0], v0[1]); b1[1] = cvt_pk_bf16(v0[2], v0[3]); b1[2] = cvt_pk_bf16(v1[0], v1[1]); b1[3] = cvt_pk_bf16(v1[2], v1[3]); }
#pragma unroll
                    for (int d = 0; d < 4; ++d) {
                        n0[d] = (unsigned)__builtin_amdgcn_update_dpp((int)b0[d], (int)b1[d], 0x128, 0xf, 0xc, false);
                        n1[d] = (unsigned)__builtin_amdgcn_update_dpp((int)b1[d], (int)b0[d], 0x128, 0xf, 0x3, false); }
                    *(u32x4*)(ob + (row - 8 * hi8) * ldc) = (u32x4){n0[0], n0[1], n0[2], n0[3]};
                    *(u32x4*)(ob + (row + 8 - 8 * hi8) * ldc) = (u32x4){n1[0], n1[1], n1[2], n1[3]}; }
        }
    }
};
__device__ __forceinline__ float dpp_ror1(float x) { return __builtin_bit_cast(float, __builtin_amdgcn_update_dpp(0, __builtin_bit_cast(int, x), 0x121, 0xf, 0xf, false)); }
__device__ __forceinline__ float dpp_ror15(float x) { return __builtin_bit_cast(float, __builtin_amdgcn_update_dpp(0, __builtin_bit_cast(int, x), 0x12f, 0xf, 0xf, false)); }
struct EpiConv {
    static constexpr bool PERM = true; static constexpr int NST = 8;
    bf16_t* A; int dff; const float* cw; const float* cb; bf16_t* SBG; bf16_t* SBV;
    __device__ __forceinline__ size_t aoff(const Unit& u, int lda) const { return (size_t)u.pm * BM * lda * 2; }
    __device__ __forceinline__ size_t boff(const Unit& u, int K) const { return (size_t)u.pn * BM * K * 2; }
    __device__ __forceinline__ void operator()(const f32x4 (&acc)[2][2][4][2], const Unit& u, int wr, int wc, int fr, int fq) const {
        const int col = u.pn * 128 + wc * 32 + 8 * fq;
        float w0[8], w1[8], w2[8], bs[8];
        { const f32x4 a0 = *(const f32x4*)(cw + col), a1 = *(const f32x4*)(cw + col + 4), b0 = *(const f32x4*)(cw + dff + col), b1 = *(const f32x4*)(cw + dff + col + 4);
          const f32x4 c0 = *(const f32x4*)(cw + 2 * dff + col), c1 = *(const f32x4*)(cw + 2 * dff + col + 4), d0 = *(const f32x4*)(cb + col), d1 = *(const f32x4*)(cb + col + 4);
#pragma unroll
          for (int e = 0; e < 4; ++e) { w0[e] = a0[e]; w0[4 + e] = a1[e]; w1[e] = b0[e]; w1[4 + e] = b1[e]; w2[e] = c0[e]; w2[4 + e] = c1[e]; bs[e] = d0[e]; bs[4 + e] = d1[e]; } }
#pragma unroll
        for (int ai = 0; ai < 2; ++ai) {
            const int blk = u.pm * 4 + ai * 2 + wr; const size_t row0 = (size_t)u.pm * BM + ai * HALF + wr * 64 + fr;
#pragma unroll
            for (int m = 0; m < 4; ++m) {
                float o[8];
#pragma unroll
                for (int e = 0; e < 8; ++e) { const float gcur = acc[ai][0][m][e >> 2][e & 3];
                    const float pm1 = (m > 0) ? acc[ai][0][m > 0 ? m - 1 : 0][e >> 2][e & 3] : 0.f, pp1 = (m < 3) ? acc[ai][0][m < 3 ? m + 1 : 3][e >> 2][e & 3] : 0.f;
                    const float ra = dpp_ror1(gcur), rb = dpp_ror1(pm1), sa = dpp_ror15(gcur), sb = dpp_ror15(pp1);
                    const float gprev = (fr == 0) ? rb : ra, gnext = (fr == 15) ? sb : sa;
                    const float x = gprev * w0[e] + gcur * w1[e] + gnext * w2[e] + bs[e];
                    o[e] = x * __builtin_amdgcn_rcpf(1.0f + __expf(-x)) * acc[ai][1][m][e >> 2][e & 3]; }
                const bool boundary = (m == 0 && fr == 0) || (m == 3 && fr == 15);
                if (!boundary) { u32x4 w; w.x = cvt_pk_bf16(o[0], o[1]); w.y = cvt_pk_bf16(o[2], o[3]); w.z = cvt_pk_bf16(o[4], o[5]); w.w = cvt_pk_bf16(o[6], o[7]);
                    *(u32x4*)(A + (row0 + m * 16) * dff + col) = w; }
                if (m == 0 || m == 3) {
                    const bool sg = (m == 0) ? (fr < 2) : (fr >= 14); const int slot = (m == 0) ? fr : 2 + (fr - 14);
                    if (sg) { const f32x4 g0 = acc[ai][0][m][0], g1 = acc[ai][0][m][1]; u32x4 w; w.x = cvt_pk_bf16(g0[0], g0[1]); w.y = cvt_pk_bf16(g0[2], g0[3]); w.z = cvt_pk_bf16(g1[0], g1[1]); w.w = cvt_pk_bf16(g1[2], g1[3]);
                        *(u32x4*)(SBG + ((size_t)blk * 4 + slot) * dff + col) = w; }
                    const bool sv = (m == 0) ? (fr == 0) : (fr == 15);
                    if (sv) { const f32x4 v0 = acc[ai][1][m][0], v1 = acc[ai][1][m][1]; u32x4 w; w.x = cvt_pk_bf16(v0[0], v0[1]); w.y = cvt_pk_bf16(v0[2], v0[3]); w.z = cvt_pk_bf16(v1[0], v1[1]); w.w = cvt_pk_bf16(v1[2], v1[3]);
                        *(u32x4*)(SBV + ((size_t)blk * 2 + (m == 0 ? 0 : 1)) * dff + col) = w; } }
            }
        }
    }
};
__device__ __forceinline__ float bf_lo(unsigned w) { return __uint_as_float(w << 16); }
__device__ __forceinline__ float bf_hi(unsigned w) { return __uint_as_float(w & 0xffff0000u); }
__device__ __forceinline__ float sigmoidf_(float x) { return __builtin_amdgcn_rcpf(1.0f + __expf(-x)); }
struct EpiMerge {
    static constexpr bool PERM = true; static constexpr int NST = 16;
    bf16_t* ACC; int ldc; const bf16_t* G; int ldg; int acol0, acol1, acol2; float scale; unsigned char* ACC8; float oscale;
    __device__ __forceinline__ size_t aoff(const Unit& u, int lda) const { const int ac = (u.z == 0) ? acol0 : acol1 + (u.z - 1) * (acol2 - acol1); return (size_t)u.pm * BM * lda * 2 + (size_t)ac * 2; }
    __device__ __forceinline__ size_t boff(const Unit& u, int K) const { return (size_t)(u.z * 2048 + u.pn * BM) * K * 2; }
    __device__ __forceinline__ void operator()(const f32x4 (&acc)[2][2][4][2], const Unit& u, int wr, int wc, int fr, int fq) const {
        const int row0 = u.pm * BM + wr * 64 + fr, col0 = u.pn * BM + wc * 32 + 8 * fq;
        typedef unsigned u32x2 __attribute__((ext_vector_type(2)));
#pragma unroll
        for (int ai = 0; ai < 2; ++ai) {
            u32x2 gv[4][2]; u32x4 pv[4][2];
#pragma unroll
            for (int m = 0; m < 4; ++m) { const size_t row = (size_t)(row0 + ai * HALF + m * 16); const unsigned char* gp = (const unsigned char*)G + row * ldg * 2 + u.z * 2048 + col0; const bf16_t* rowp = ACC + row * ldc + col0;
#pragma unroll
                for (int bj = 0; bj < 2; ++bj) { gv[m][bj] = *(const u32x2*)(gp + bj * HALF); pv[m][bj] = (u32x4){0u, 0u, 0u, 0u}; if (u.z != 0) pv[m][bj] = *(const u32x4*)(rowp + bj * HALF); } }
#pragma unroll
            for (int m = 0; m < 4; ++m) { const size_t row = (size_t)(row0 + ai * HALF + m * 16); bf16_t* rowp = ACC + row * ldc + col0; unsigned char* r8 = ACC8 + row * 2048 + col0;
#pragma unroll
                for (int bj = 0; bj < 2; ++bj) { const f32x4 v0 = acc[ai][bj][m][0] * scale, v1 = acc[ai][bj][m][1] * scale; const u32x2 g = gv[m][bj]; const u32x4 p = pv[m][bj];
                    const auto g0 = __builtin_amdgcn_cvt_pk_f32_fp8((int)g.x, false), g1 = __builtin_amdgcn_cvt_pk_f32_fp8((int)g.x, true), g2 = __builtin_amdgcn_cvt_pk_f32_fp8((int)g.y, false), g3 = __builtin_amdgcn_cvt_pk_f32_fp8((int)g.y, true);
#define SG_(x) __builtin_amdgcn_rcpf(1.0f + __builtin_amdgcn_exp2f(x))
                    float o[8];
                    o[0] = bf_lo(p.x) + SG_(g0[0]) * v0[0]; o[1] = bf_hi(p.x) + SG_(g0[1]) * v0[1];
                    o[2] = bf_lo(p.y) + SG_(g1[0]) * v0[2]; o[3] = bf_hi(p.y) + SG_(g1[1]) * v0[3];
                    o[4] = bf_lo(p.z) + SG_(g2[0]) * v1[0]; o[5] = bf_hi(p.z) + SG_(g2[1]) * v1[1];
                    o[6] = bf_lo(p.w) + SG_(g3[0]) * v1[2]; o[7] = bf_hi(p.w) + SG_(g3[1]) * v1[3];
#undef SG_
                    if (u.z != 2) { u32x4 w; w.x = cvt_pk_bf16(o[0], o[1]); w.y = cvt_pk_bf16(o[2], o[3]); w.z = cvt_pk_bf16(o[4], o[5]); w.w = cvt_pk_bf16(o[6], o[7]);
                        *(u32x4*)(rowp + bj * HALF) = w; }
                    else { int w0 = 0, w1 = 0; w0 = __builtin_amdgcn_cvt_pk_fp8_f32(o[0] * oscale, o[1] * oscale, w0, false); w0 = __builtin_amdgcn_cvt_pk_fp8_f32(o[2] * oscale, o[3] * oscale, w0, true);
                        w1 = __builtin_amdgcn_cvt_pk_fp8_f32(o[4] * oscale, o[5] * oscale, w1, false); w1 = __builtin_amdgcn_cvt_pk_fp8_f32(o[6] * oscale, o[7] * oscale, w1, true);
                        *(u32x2*)(r8 + bj * HALF) = (u32x2){(unsigned)w0, (unsigned)w1}; } } }
        }
    }
};

typedef int i32x4 __attribute__((ext_vector_type(4)));
typedef int i32x8 __attribute__((ext_vector_type(8)));
template <class Epi, bool ALIGN_EPI, bool SP2, bool FP8 = false>
__device__ __forceinline__ void gemm_phase(PG8_LAS unsigned char* lds, const Gemm g, const StaticOrder& S, const Epi& E) {
    int tid_ = threadIdx.x; asm volatile("" : "+v"(tid_));
    const int tid = tid_, wid = __builtin_amdgcn_readfirstlane(tid >> 6), lane = tid & 63, wr = wid >> 2, wc = wid & 3, fr = lane & 15, fq = lane >> 4;
    const int K = g.K, nt = K / BK, lda = g.lda;
    unsigned voffA[2], voffB[2];
#pragma unroll
    for (int i = 0; i < 2; ++i) { int R, C; stage_rc(tid * 16 + i * 8192, R, C); const int Rb = Epi::PERM ? ((R & ~31) + perm32(R & 31)) : R;
        voffA[i] = (unsigned)(R * lda + C) * 2u; voffB[i] = (unsigned)(Rb * K + C) * 2u; }
    const size_t kstep = (size_t)(BK * 2), kstepA = (size_t)g.kstepA;
    const size_t hstepA = (size_t)HALF * lda * 2, hstepB = (size_t)HALF * K * 2;
    const unsigned ldsw = (unsigned)wid * 1024u;
    const int aoff = lds_byte(wr * 64 + fr, fq * 8), boff = lds_byte(wc * 32 + fr, fq * 8);
#define PG8_SA(b, h) (((b) * 2 + (h)) * HTB)
#define PG8_SB(b, h) ((4 + (b) * 2 + (h)) * HTB)
#define PG8_STAGE(bufoff, gbase, voff) do { _Pragma("unroll") for (int _i = 0; _i < 2; ++_i) \
        __builtin_amdgcn_global_load_lds((const unsigned*)((const char*)(gbase) + (voff)[_i]), (PG8_LAS unsigned*)(lds + (bufoff) + ldsw + _i * 8192), 16, 0, 0); } while (0)
#define PG8_LDA(dst, b, h) do { _Pragma("unroll") for (int m = 0; m < 4; ++m) { const i32x4 lo_ = *(const PG8_LAS i32x4*)(lds + PG8_SA(b, h) + aoff + m * 2048), hi_ = *(const PG8_LAS i32x4*)(lds + PG8_SA(b, h) + aoff + m * 2048 + 1024); dst[m] = __builtin_shufflevector(lo_, hi_, 0, 1, 2, 3, 4, 5, 6, 7); } } while (0)
#define PG8_LDB(dst, b, h) do { _Pragma("unroll") for (int n = 0; n < 2; ++n) { const i32x4 lo_ = *(const PG8_LAS i32x4*)(lds + PG8_SB(b, h) + boff + n * 2048), hi_ = *(const PG8_LAS i32x4*)(lds + PG8_SB(b, h) + boff + n * 2048 + 1024); dst[n] = __builtin_shufflevector(lo_, hi_, 0, 1, 2, 3, 4, 5, 6, 7); } } while (0)
#define PG8_LO(x) __builtin_bit_cast(bf16x8, __builtin_shufflevector(x, x, 0, 1, 2, 3))
#define PG8_HI(x) __builtin_bit_cast(bf16x8, __builtin_shufflevector(x, x, 4, 5, 6, 7))
#define PG8_MMA(ai, bj, At, Bt) do { __builtin_amdgcn_s_setprio(1); if constexpr (FP8) { _Pragma("unroll") for (int m = 0; m < 4; ++m) _Pragma("unroll") for (int n = 0; n < 2; ++n) \
        asm volatile("v_mfma_scale_f32_16x16x128_f8f6f4 %0, %1, %2, %0, %3, %3 op_sel_hi:[0,0,0]" : "+v"(acc[ai][bj][m][n]) : "v"(Bt[n]), "v"(At[m]), "v"(one_scale)); } else { \
        _Pragma("unroll") for (int m = 0; m < 4; ++m) _Pragma("unroll") for (int n = 0; n < 2; ++n) { \
        acc[ai][bj][m][n] = __builtin_amdgcn_mfma_f32_16x16x32_bf16(PG8_LO(Bt[n]), PG8_LO(At[m]), acc[ai][bj][m][n], 0, 0, 0); \
        acc[ai][bj][m][n] = __builtin_amdgcn_mfma_f32_16x16x32_bf16(PG8_HI(Bt[n]), PG8_HI(At[m]), acc[ai][bj][m][n], 0, 0, 0); } } __builtin_amdgcn_s_setprio(0); } while (0)
#define PG8_WAIT_V(n) asm volatile("s_waitcnt vmcnt(" #n ")" ::: "memory")
#define PG8_WAIT_VN(N) asm volatile("s_waitcnt vmcnt(%0)" :: "n"(N) : "memory")
#define PG8_WAIT_L(n) asm volatile("s_waitcnt lgkmcnt(" #n ")" ::: "memory")
#define PG8_BAR __builtin_amdgcn_s_barrier()
#define PG8_SCHED __builtin_amdgcn_sched_barrier(0)
    Unit cur, nxt; int ui = 0;
    if (!S.next(0, cur)) return;
    f32x4 acc[2][2][4][2];
#pragma unroll
    for (int a = 0; a < 2; ++a)
#pragma unroll
        for (int b = 0; b < 2; ++b)
#pragma unroll
            for (int m = 0; m < 4; ++m)
#pragma unroll
                for (int n = 0; n < 2; ++n) acc[a][b][m][n] = (f32x4){0.f, 0.f, 0.f, 0.f};
    i32x8 At[4], B0[2], B1[2];
    const int one_scale = 0x7F7F7F7F;
    const char* cA = (const char*)g.A + E.aoff(cur, lda); const char* cB = (const char*)g.Bt + E.boff(cur, K);
    if constexpr (SP2) {
        PG8_STAGE(PG8_SB(0, 0), cB, voffB); PG8_STAGE(PG8_SB(0, 1), cB + hstepB, voffB); PG8_STAGE(PG8_SA(0, 0), cA, voffA); PG8_STAGE(PG8_SA(0, 1), cA + hstepA, voffA);
        if (wr == 1) PG8_BAR;
        PG8_WAIT_V(2); PG8_BAR;
        PG8_STAGE(PG8_SB(1, 0), cB + kstep, voffB); PG8_STAGE(PG8_SA(1, 0), cA + kstepA, voffA); PG8_STAGE(PG8_SB(1, 1), cB + hstepB + kstep, voffB);
        PG8_WAIT_V(6); PG8_BAR;
    } else {
        PG8_STAGE(PG8_SB(0, 0), cB, voffB); PG8_STAGE(PG8_SA(0, 0), cA, voffA); PG8_STAGE(PG8_SB(0, 1), cB + hstepB, voffB); PG8_STAGE(PG8_SA(0, 1), cA + hstepA, voffA);
        if (wr == 1) PG8_BAR;
        PG8_WAIT_V(4); PG8_BAR;
        PG8_STAGE(PG8_SB(1, 0), cB + kstep, voffB); PG8_STAGE(PG8_SA(1, 0), cA + kstepA, voffA); PG8_STAGE(PG8_SB(1, 1), cB + hstepB + kstep, voffB);
        PG8_WAIT_V(6); PG8_BAR;
    }
    for (;;) {
        const bool has_next = S.next(ui + 1, nxt);
        const char* nA = has_next ? (const char*)g.A + E.aoff(nxt, lda) : cA; const char* nB = has_next ? (const char*)g.Bt + E.boff(nxt, K) : cB;
        for (int t = 0; t < nt; t += 2) {
            const bool last = (t == nt - 2);
            const char* a1 = cA + (size_t)(t + 1) * kstepA;
            const char* a2 = last ? nA : cA + (size_t)(t + 2) * kstepA; const char* b2 = last ? nB : cB + (size_t)(t + 2) * kstep;
            const char* a3 = a2 + kstepA; const char* b3 = b2 + kstep;
            if constexpr (SP2) {
            int relax_ = __builtin_amdgcn_readfirstlane(((t == 0) && (ui > 0)) ? 1 : 0); asm volatile("" : "+s"(relax_));
#define PG8_WAIT_R() do { if (relax_) PG8_WAIT_VN(8 + Epi::NST); else PG8_WAIT_V(8); } while (0)
            PG8_LDB(B0, 0, 0); PG8_LDB(B1, 0, 1); PG8_SCHED; PG8_LDA(At, 0, 0); PG8_STAGE(PG8_SA(1, 1), a1 + hstepA, voffA);
            PG8_WAIT_R(); PG8_WAIT_L(0); PG8_BAR; PG8_MMA(0, 0, At, B0); PG8_MMA(0, 1, At, B1); PG8_BAR; PG8_SCHED;
            PG8_LDA(At, 0, 1); PG8_STAGE(PG8_SB(0, 0), b2, voffB); PG8_STAGE(PG8_SB(0, 1), b2 + hstepB, voffB); PG8_STAGE(PG8_SA(0, 0), a2, voffA);
            PG8_WAIT_R(); PG8_WAIT_L(0); PG8_BAR; PG8_MMA(1, 0, At, B0); PG8_MMA(1, 1, At, B1); PG8_BAR; PG8_SCHED;
#undef PG8_WAIT_R
            PG8_LDB(B0, 1, 0); PG8_LDB(B1, 1, 1); PG8_SCHED; PG8_LDA(At, 1, 0); PG8_STAGE(PG8_SA(0, 1), a2 + hstepA, voffA);
            PG8_WAIT_V(8); PG8_WAIT_L(0); PG8_BAR; PG8_MMA(0, 0, At, B0); PG8_MMA(0, 1, At, B1); PG8_BAR; PG8_SCHED;
            PG8_LDA(At, 1, 1); PG8_STAGE(PG8_SB(1, 0), b3, voffB); PG8_STAGE(PG8_SB(1, 1), b3 + hstepB, voffB); PG8_STAGE(PG8_SA(1, 0), a3, voffA);
            PG8_WAIT_V(8); PG8_WAIT_L(0); PG8_BAR; PG8_MMA(1, 0, At, B0); PG8_MMA(1, 1, At, B1); PG8_BAR; PG8_SCHED;
            } else {
            PG8_LDB(B0, 0, 0); PG8_SCHED; PG8_LDA(At, 0, 0); PG8_STAGE(PG8_SA(1, 1), a1 + hstepA, voffA);
            PG8_WAIT_L(8); PG8_BAR; PG8_WAIT_L(0); PG8_MMA(0, 0, At, B0); PG8_BAR; PG8_SCHED;
            PG8_LDB(B1, 0, 1); PG8_STAGE(PG8_SB(0, 0), b2, voffB);
            PG8_BAR; PG8_WAIT_L(0); PG8_MMA(0, 1, At, B1); PG8_BAR;
            PG8_LDA(At, 0, 1); PG8_STAGE(PG8_SA(0, 0), a2, voffA);
            PG8_BAR; PG8_WAIT_L(0); PG8_MMA(1, 0, At, B0); PG8_BAR; PG8_SCHED;
            PG8_STAGE(PG8_SB(0, 1), b2 + hstepB, voffB);
            PG8_WAIT_V(6); PG8_BAR; PG8_MMA(1, 1, At, B1); PG8_BAR;
            PG8_LDB(B0, 1, 0); PG8_SCHED; PG8_LDA(At, 1, 0); PG8_STAGE(PG8_SA(0, 1), a2 + hstepA, voffA);
            PG8_WAIT_L(8); PG8_BAR; PG8_WAIT_L(0); PG8_MMA(0, 0, At, B0); PG8_BAR; PG8_SCHED;
            PG8_LDB(B1, 1, 1); PG8_STAGE(PG8_SB(1, 0), b3, voffB);
            PG8_BAR; PG8_WAIT_L(0); PG8_MMA(0, 1, At, B1); PG8_BAR;
            PG8_LDA(At, 1, 1); PG8_STAGE(PG8_SA(1, 0), a3, voffA);
            PG8_BAR; PG8_WAIT_L(0); PG8_MMA(1, 0, At, B0); PG8_BAR; PG8_SCHED;
            PG8_STAGE(PG8_SB(1, 1), b3 + hstepB, voffB);
            PG8_WAIT_V(6); PG8_BAR; PG8_MMA(1, 1, At, B1); PG8_BAR;
            }
        }
        if constexpr (ALIGN_EPI) { if (wr == 0) PG8_BAR; }
        if constexpr (FP8) {
            asm volatile("s_nop 15\n\ts_nop 15" : "+v"(acc[0][0][0][0]), "+v"(acc[0][0][0][1]), "+v"(acc[0][0][1][0]), "+v"(acc[0][0][1][1]), "+v"(acc[0][0][2][0]), "+v"(acc[0][0][2][1]), "+v"(acc[0][0][3][0]), "+v"(acc[0][0][3][1]),
                         "+v"(acc[0][1][0][0]), "+v"(acc[0][1][0][1]), "+v"(acc[0][1][1][0]), "+v"(acc[0][1][1][1]), "+v"(acc[0][1][2][0]), "+v"(acc[0][1][2][1]), "+v"(acc[0][1][3][0]), "+v"(acc[0][1][3][1]));
            asm volatile("" : "+v"(acc[1][0][0][0]), "+v"(acc[1][0][0][1]), "+v"(acc[1][0][1][0]), "+v"(acc[1][0][1][1]), "+v"(acc[1][0][2][0]), "+v"(acc[1][0][2][1]), "+v"(acc[1][0][3][0]), "+v"(acc[1][0][3][1]),
                         "+v"(acc[1][1][0][0]), "+v"(acc[1][1][0][1]), "+v"(acc[1][1][1][0]), "+v"(acc[1][1][1][1]), "+v"(acc[1][1][2][0]), "+v"(acc[1][1][2][1]), "+v"(acc[1][1][3][0]), "+v"(acc[1][1][3][1])); }
        E(acc, cur, wr, wc, fr, fq);
        if (!has_next) break;
#pragma unroll
        for (int a = 0; a < 2; ++a)
#pragma unroll
            for (int b = 0; b < 2; ++b)
#pragma unroll
                for (int m = 0; m < 4; ++m)
#pragma unroll
                    for (int n = 0; n < 2; ++n) acc[a][b][m][n] = (f32x4){0.f, 0.f, 0.f, 0.f};
        cur = nxt; cA = nA; cB = nB; ++ui;
        if constexpr (ALIGN_EPI) { if (wr == 1) PG8_BAR; }
    }
    PG8_WAIT_V(0);
    if constexpr (!ALIGN_EPI) { if (wr == 0) PG8_BAR; }
    PG8_BAR;
#undef PG8_SA
#undef PG8_SB
#undef PG8_STAGE
#undef PG8_LDA
#undef PG8_LDB
#undef PG8_MMA
#undef PG8_LO
#undef PG8_HI
#undef PG8_WAIT_V
#undef PG8_WAIT_VN
#undef PG8_WAIT_L
#undef PG8_BAR
#undef PG8_SCHED
}
}
namespace att {
#define ATT_LAS __attribute__((address_space(3)))
typedef unsigned short bf16;
using bf16x8 = __attribute__((ext_vector_type(8))) short;
using s16x4  = __attribute__((ext_vector_type(4))) short;
using f32x16 = __attribute__((ext_vector_type(16))) float;
using u32x4  = __attribute__((ext_vector_type(4))) unsigned;
using i32x4  = __attribute__((ext_vector_type(4))) int;
using i32x8  = __attribute__((ext_vector_type(8))) int;
constexpr int NW = 8, QBLK = 32, KVBLK = 64;
constexpr int SHM_V = 16384, SHM_K = 16384, SHM_KR = 8192;
constexpr int OFF_V = 0, OFF_K = 2 * SHM_V, OFF_KR = OFF_K + 2 * SHM_K, OFF_WS = OFF_KR + 2 * SHM_KR, OFF_TAB = OFF_WS + NW * 64 * 4, ATT_LDS_BYTES = OFF_TAB + 15 * 128 * 4, OFF_OST = 98304  ;
constexpr float YS = 8.0f;
static_assert(ATT_LDS_BYTES <= OFF_OST, "attention LDS map");
#define KSWZ(row, colB) ((row) * 256 + ((colB) ^ (((row) & 7) << 4)))
#define KRSWZ(row, colB) ((row) * 128 + ((colB) ^ (((row) & 7) << 4)))
#define K8SWZ(row, colB) ((row) * 128 + ((colB) ^ ((((row) >> 1) & 7) << 4)))
#define SBAR() __builtin_amdgcn_sched_barrier(0)
__device__ __forceinline__ int crow(int r, int hi) { return (r & 3) + 8 * (r >> 2) + 4 * hi; }
__device__ __forceinline__ unsigned cvtpk(float lo, float hi) { unsigned r; asm volatile("v_cvt_pk_bf16_f32 %0, %1, %2" : "=v"(r) : "v"(lo), "v"(hi)); return r; }

template <int DQK> struct Sc { static constexpr float SCALE = (DQK == 192) ? 0.07216878364870322f : 0.08838834764831845f; };

template <int DQK, int F8>
__device__ __forceinline__ void partialSM(f32x16& p0, f32x16& p1, float& m_reg, float& mn, float& alpha) {
  constexpr float SCALE = Sc<DQK>::SCALE; constexpr float C = SCALE * 1.4426950408889634f; constexpr float THR = F8 ? 3.f : 8.f;
  float pmax = p0[0];
#pragma unroll
  for (int r = 1; r < 16; ++r) pmax = fmaxf(pmax, p0[r]);
#pragma unroll
  for (int r = 0; r < 16; ++r) pmax = fmaxf(pmax, p1[r]);
  { auto rr = __builtin_amdgcn_permlane32_swap(__float_as_uint(pmax), __float_as_uint(pmax), false, false);
    pmax = fmaxf(__uint_as_float(rr[0]), __uint_as_float(rr[1])); }
  if (__builtin_expect(__all(pmax - m_reg <= THR / SCALE), 1)) { mn = m_reg; alpha = 1.f; }
  else { mn = fmaxf(m_reg, pmax); alpha = __builtin_amdgcn_exp2f((m_reg - mn) * C); m_reg = mn; }
  float mnC = -mn * C + (F8 ? 4.f : 0.f);
#pragma unroll
  for (int r = 0; r < 16; ++r) p0[r] = fmaf(p0[r], C, mnC);
#pragma unroll
  for (int r = 0; r < 16; ++r) p1[r] = fmaf(p1[r], C, mnC);
#pragma unroll
  for (int r = 0; r < 16; ++r) p0[r] = __builtin_amdgcn_exp2f(p0[r]);
}
__device__ __forceinline__ void finishSM(f32x16& p0, f32x16& p1, float alpha, float& l_reg, bf16x8& pa0, bf16x8& pa1, bf16x8& pa2, bf16x8& pa3) {
#pragma unroll
  for (int r = 0; r < 16; ++r) p1[r] = __builtin_amdgcn_exp2f(p1[r]);
  float ps = 0;
#pragma unroll
  for (int r = 0; r < 16; ++r) ps += p0[r];
#pragma unroll
  for (int r = 0; r < 16; ++r) ps += p1[r];
  { auto rr = __builtin_amdgcn_permlane32_swap(__float_as_uint(ps), __float_as_uint(ps), false, false);
    ps = __uint_as_float(rr[0]) + __uint_as_float(rr[1]); }
  l_reg = l_reg * alpha + ps;
#define PK4(P, BASE, OUT) do { unsigned a0 = cvtpk(P[BASE + 0], P[BASE + 1]), a1 = cvtpk(P[BASE + 2], P[BASE + 3]);   \
    unsigned b0 = cvtpk(P[BASE + 4], P[BASE + 5]), b1 = cvtpk(P[BASE + 6], P[BASE + 7]);                              \
    auto r0 = __builtin_amdgcn_permlane32_swap(a0, b0, false, false); auto r1 = __builtin_amdgcn_permlane32_swap(a1, b1, false, false); \
    u32x4 w = {r0[0], r1[0], r0[1], r1[1]}; OUT = *reinterpret_cast<bf16x8*>(&w); } while (0)
  PK4(p0, 0, pa0); PK4(p0, 8, pa1); PK4(p1, 0, pa2); PK4(p1, 8, pa3);
#undef PK4
}
template <int DQK>
__device__ __forceinline__ void qkt(f32x16& p0, f32x16& p1, const ATT_LAS char* Ks, const ATT_LAS char* Krs, const bf16x8* qr, const ATT_LAS char* Qrs, int r32, int hi) {
  p0 = f32x16{}; p1 = f32x16{};
#pragma unroll
  for (int d0 = 0; d0 < 8; ++d0) { int cb = (d0 * 16 + hi * 8) * 2;
    bf16x8 b0 = *reinterpret_cast<const ATT_LAS bf16x8*>(Ks + KSWZ(r32, cb));
    bf16x8 b1 = *reinterpret_cast<const ATT_LAS bf16x8*>(Ks + KSWZ(32 + r32, cb));
    p0 = __builtin_amdgcn_mfma_f32_32x32x16_bf16(b0, qr[d0], p0, 0, 0, 0);
    p1 = __builtin_amdgcn_mfma_f32_32x32x16_bf16(b1, qr[d0], p1, 0, 0, 0); }
  if constexpr (DQK == 192) {
#pragma unroll
    for (int d0 = 0; d0 < 4; ++d0) { int cb = (d0 * 16 + hi * 8) * 2;
      bf16x8 b0 = *reinterpret_cast<const ATT_LAS bf16x8*>(Krs + KRSWZ(r32, cb));
      bf16x8 b1 = *reinterpret_cast<const ATT_LAS bf16x8*>(Krs + KRSWZ(32 + r32, cb));
      p0 = __builtin_amdgcn_mfma_f32_32x32x16_bf16(b0, qr[8 + d0], p0, 0, 0, 0);
      p1 = __builtin_amdgcn_mfma_f32_32x32x16_bf16(b1, qr[8 + d0], p1, 0, 0, 0); }
  }
}
#define KR8SWZ(row, c16) ((row) * 64 + ((((c16) ^ (((row) >> 2) & 3))) << 4))
template <int DQK>
__device__ __forceinline__ void qkt8(f32x16& p0, f32x16& p1, const ATT_LAS char* Ks, const ATT_LAS char* Krs, const i32x8 (&q8)[DQK / 64], int r32, int hi) {
  const int one = 0x7F7F7F7F;
#define LD32(dst, base, o0, o1) const i32x4 dst##_l = *reinterpret_cast<const ATT_LAS i32x4*>((base) + (o0)), dst##_h = *reinterpret_cast<const ATT_LAS i32x4*>((base) + (o1)); const i32x8 dst = __builtin_shufflevector(dst##_l, dst##_h, 0, 1, 2, 3, 4, 5, 6, 7)
  { const int cb = hi * 32;
    LD32(a0, Ks, K8SWZ(r32, cb), K8SWZ(r32, cb + 16)); LD32(a1, Ks, K8SWZ(32 + r32, cb), K8SWZ(32 + r32, cb + 16));
    asm volatile("v_mfma_scale_f32_32x32x64_f8f6f4 %0, %1, %2, 0, %3, %3 op_sel_hi:[0,0,0]" : "=&v"(p0) : "v"(a0), "v"(q8[0]), "v"(one));
    asm volatile("v_mfma_scale_f32_32x32x64_f8f6f4 %0, %1, %2, 0, %3, %3 op_sel_hi:[0,0,0]" : "=&v"(p1) : "v"(a1), "v"(q8[0]), "v"(one)); }
  { const int cb = 64 + hi * 32;
    LD32(a0, Ks, K8SWZ(r32, cb), K8SWZ(r32, cb + 16)); LD32(a1, Ks, K8SWZ(32 + r32, cb), K8SWZ(32 + r32, cb + 16));
    asm volatile("v_mfma_scale_f32_32x32x64_f8f6f4 %0, %1, %2, %0, %3, %3 op_sel_hi:[0,0,0]" : "+v"(p0) : "v"(a0), "v"(q8[1]), "v"(one));
    asm volatile("v_mfma_scale_f32_32x32x64_f8f6f4 %0, %1, %2, %0, %3, %3 op_sel_hi:[0,0,0]" : "+v"(p1) : "v"(a1), "v"(q8[1]), "v"(one)); }
  if constexpr (DQK == 192) {
    LD32(a0, Krs, KR8SWZ(r32, 2 * hi), KR8SWZ(r32, 2 * hi + 1)); LD32(a1, Krs, KR8SWZ(32 + r32, 2 * hi), KR8SWZ(32 + r32, 2 * hi + 1));
    asm volatile("v_mfma_scale_f32_32x32x64_f8f6f4 %0, %1, %2, %0, %3, %3 op_sel_hi:[0,0,0]" : "+v"(p0) : "v"(a0), "v"(q8[DQK / 64 - 1]), "v"(one));
    asm volatile("v_mfma_scale_f32_32x32x64_f8f6f4 %0, %1, %2, %0, %3, %3 op_sel_hi:[0,0,0]" : "+v"(p1) : "v"(a1), "v"(q8[DQK / 64 - 1]), "v"(one)); }
#undef LD32
  asm volatile("s_nop 15\n\ts_nop 7" : "+v"(p0), "+v"(p1));
}
__device__ __forceinline__ int v_st(int k, int c) { const int kk = (k & ~0xC) | ((k & 4) << 1) | ((k & 8) >> 1); return ((kk >> 3) * 4 + (c >> 5)) * 512 + ((kk & 7) * 32 + (c & 31)) * 2; }
__device__ __forceinline__ int v_rd_base(int lane) { return ((lane & 3) << 3) | (((lane >> 2) & 3) << 6) | (((lane >> 4) & 1) << 5) | (((lane >> 5) & 1) << 8); }
constexpr int v_rd_off(int d0, int ks, int half) { return d0 * 512 + ks * 4096 + half * 2048; }
template <int OFF> __device__ __forceinline__ s16x4 tr_read(int vb) {
  s16x4 r; asm volatile("ds_read_b64_tr_b16 %0, %1 offset:%2" : "=&v"(r) : "v"(vb), "i"(OFF) : "memory"); return r;
}
template <int D0> __device__ __forceinline__ void pv_one(f32x16& od, int vb, bf16x8 pa0, bf16x8 pa1, bf16x8 pa2, bf16x8 pa3) {
  const s16x4 l0 = tr_read<v_rd_off(D0, 0, 0)>(vb), h0 = tr_read<v_rd_off(D0, 0, 1)>(vb), l1 = tr_read<v_rd_off(D0, 1, 0)>(vb), h1 = tr_read<v_rd_off(D0, 1, 1)>(vb);
  const s16x4 l2 = tr_read<v_rd_off(D0, 2, 0)>(vb), h2 = tr_read<v_rd_off(D0, 2, 1)>(vb), l3 = tr_read<v_rd_off(D0, 3, 0)>(vb), h3 = tr_read<v_rd_off(D0, 3, 1)>(vb);
  asm volatile("s_waitcnt lgkmcnt(0)" ::: "memory"); SBAR();
#define PK(L, H) (bf16x8){L[0], L[1], L[2], L[3], H[0], H[1], H[2], H[3]}
  od = __builtin_amdgcn_mfma_f32_32x32x16_bf16(pa0, PK(l0, h0), od, 0, 0, 0);
  od = __builtin_amdgcn_mfma_f32_32x32x16_bf16(pa1, PK(l1, h1), od, 0, 0, 0);
  od = __builtin_amdgcn_mfma_f32_32x32x16_bf16(pa2, PK(l2, h2), od, 0, 0, 0);
  od = __builtin_amdgcn_mfma_f32_32x32x16_bf16(pa3, PK(l3, h3), od, 0, 0, 0);
#undef PK
}
__device__ __forceinline__ void pv_d0(f32x16* o, int vb, bf16x8 pa0, bf16x8 pa1, bf16x8 pa2, bf16x8 pa3) {
  pv_one<0>(o[0], vb, pa0, pa1, pa2, pa3); pv_one<1>(o[1], vb, pa0, pa1, pa2, pa3); pv_one<2>(o[2], vb, pa0, pa1, pa2, pa3); pv_one<3>(o[3], vb, pa0, pa1, pa2, pa3);
}

__device__ __forceinline__ void finishSM8(f32x16& p0, f32x16& p1, float alpha, float& l_reg, i32x8& P8) {
#pragma unroll
  for (int r = 0; r < 16; ++r) p1[r] = __builtin_amdgcn_exp2f(p1[r]);
  float ps = 0;
#pragma unroll
  for (int r = 0; r < 16; ++r) ps += p0[r];
#pragma unroll
  for (int r = 0; r < 16; ++r) ps += p1[r];
  { auto rr = __builtin_amdgcn_permlane32_swap(__float_as_uint(ps), __float_as_uint(ps), false, false);
    ps = __uint_as_float(rr[0]) + __uint_as_float(rr[1]); }
  l_reg = l_reg * alpha + ps;
  int w[8];
#pragma unroll
  for (int k = 0; k < 4; ++k) { int x = 0; x = __builtin_amdgcn_cvt_pk_fp8_f32(p0[4 * k], p0[4 * k + 1], x, false); x = __builtin_amdgcn_cvt_pk_fp8_f32(p0[4 * k + 2], p0[4 * k + 3], x, true); w[k] = x;
    int y = 0; y = __builtin_amdgcn_cvt_pk_fp8_f32(p1[4 * k], p1[4 * k + 1], y, false); y = __builtin_amdgcn_cvt_pk_fp8_f32(p1[4 * k + 2], p1[4 * k + 3], y, true); w[4 + k] = y; }
  P8 = (i32x8){w[0], w[1], w[2], w[3], w[4], w[5], w[6], w[7]};
}
using u32x2 = __attribute__((ext_vector_type(2))) unsigned;
template <int OFF> __device__ __forceinline__ u32x2 tr8_read(int vb) {
  u32x2 r; asm volatile("ds_read_b64_tr_b8 %0, %1 offset:%2" : "=&v"(r) : "v"(vb), "i"(OFF) : "memory"); return r;
}
template <bool LAST> __device__ __forceinline__ void pv8_one(f32x16& od, int vb, const i32x8& P8) {
  const u32x2 r0 = tr8_read<0>(vb), r1 = tr8_read<2048>(vb), r2 = tr8_read<4096>(vb), r3 = tr8_read<6144>(vb);
  asm volatile("s_waitcnt lgkmcnt(0)" ::: "memory"); SBAR();
  const i32x8 vf = (i32x8){(int)r0.x, (int)r0.y, (int)r1.x, (int)r1.y, (int)r2.x, (int)r2.y, (int)r3.x, (int)r3.y};
  const int one = 0x7F7F7F7F;
  asm volatile("v_mfma_scale_f32_32x32x64_f8f6f4 %0, %1, %2, %0, %3, %3 op_sel_hi:[0,0,0]" : "+v"(od) : "v"(P8), "v"(vf), "v"(one));
}
__device__ __forceinline__ void pv8(f32x16* o, const int (&vb)[4], int boff, const i32x8& P8) {
  pv8_one<false>(o[0], vb[0] + boff, P8); pv8_one<false>(o[1], vb[1] + boff, P8); pv8_one<false>(o[2], vb[2] + boff, P8); pv8_one<true>(o[3], vb[3] + boff, P8);
  asm volatile("s_nop 15\n\ts_nop 7" : "+v"(o[0]), "+v"(o[1]), "+v"(o[2]), "+v"(o[3]));
}


#define ATT_LD32(dst, base, o0, o1) const i32x4 dst##_l = *reinterpret_cast<const ATT_LAS i32x4*>((base) + (o0)), dst##_h = *reinterpret_cast<const ATT_LAS i32x4*>((base) + (o1)); const i32x8 dst = __builtin_shufflevector(dst##_l, dst##_h, 0, 1, 2, 3, 4, 5, 6, 7)
#define ATT_MF0(ACC, A_, B_, TIE) asm volatile("v_mfma_scale_f32_32x32x64_f8f6f4 %0, %2, %3, 0, %4, %4 op_sel_hi:[0,0,0]" : "=&v"(ACC), "+v"(TIE) : "v"(A_), "v"(B_), "v"(one) : "memory")
#define ATT_MF1(ACC, A_, B_, TIE) asm volatile("v_mfma_scale_f32_32x32x64_f8f6f4 %0, %2, %3, %0, %4, %4 op_sel_hi:[0,0,0]" : "+v"(ACC), "+v"(TIE) : "v"(A_), "v"(B_), "v"(one) : "memory")
#define ATT_MF2(ACC, A_, B_, T0, T1) asm volatile("v_mfma_scale_f32_32x32x64_f8f6f4 %0, %3, %4, %0, %5, %5 op_sel_hi:[0,0,0]" : "+v"(ACC), "+v"(T0), "+v"(T1) : "v"(A_), "v"(B_), "v"(one))
template <int A, int B> __device__ __forceinline__ void exp_rng(f32x16& p) {
#pragma unroll
  for (int r = A; r < B; ++r) p[r] = __builtin_amdgcn_exp2f(p[r]);
}
template <int DQK>
__device__ __forceinline__ void fusedA(f32x16& n0, f32x16& n1, const ATT_LAS char* Ks, const ATT_LAS char* Krs, const i32x8 (&q8)[DQK / 64], int r32, int hi, f32x16& pp0, f32x16& pp1, float alp, float& l_reg, i32x8& P8) {
  const int one = 0x7F7F7F7F;
  const int cb = hi * 32, cc = 64 + hi * 32;
  ATT_LD32(a0, Ks, K8SWZ(r32, cb), K8SWZ(r32, cb + 16)); ATT_LD32(a1, Ks, K8SWZ(32 + r32, cb), K8SWZ(32 + r32, cb + 16));
  if constexpr (DQK == 192) {
    ATT_MF0(n0, a0, q8[0], pp1); ATT_LD32(b0, Ks, K8SWZ(r32, cc), K8SWZ(r32, cc + 16)); exp_rng<0, 3>(pp1);
    ATT_MF0(n1, a1, q8[0], pp1); ATT_LD32(b1, Ks, K8SWZ(32 + r32, cc), K8SWZ(32 + r32, cc + 16)); exp_rng<3, 6>(pp1);
    ATT_MF1(n0, b0, q8[1], pp1); ATT_LD32(c0, Krs, KR8SWZ(r32, 2 * hi), KR8SWZ(r32, 2 * hi + 1)); exp_rng<6, 9>(pp1);
    ATT_MF1(n1, b1, q8[1], pp1); ATT_LD32(c1, Krs, KR8SWZ(32 + r32, 2 * hi), KR8SWZ(32 + r32, 2 * hi + 1)); exp_rng<9, 12>(pp1);
    ATT_MF1(n0, c0, q8[2], pp1); exp_rng<12, 14>(pp1);
    ATT_MF1(n1, c1, q8[2], pp1); exp_rng<14, 16>(pp1);
  } else {
    ATT_MF0(n0, a0, q8[0], pp1); ATT_LD32(b0, Ks, K8SWZ(r32, cc), K8SWZ(r32, cc + 16)); exp_rng<0, 4>(pp1);
    ATT_MF0(n1, a1, q8[0], pp1); ATT_LD32(b1, Ks, K8SWZ(32 + r32, cc), K8SWZ(32 + r32, cc + 16)); exp_rng<4, 8>(pp1);
    ATT_MF1(n0, b0, q8[1], pp1); exp_rng<8, 12>(pp1);
    ATT_MF1(n1, b1, q8[1], pp1); exp_rng<12, 16>(pp1);
  }
  typedef float f32x2_ __attribute__((ext_vector_type(2)));
  f32x2_ ps2 = {pp0[0], pp0[1]};
#pragma unroll
  for (int r = 2; r < 16; r += 2) ps2 += (f32x2_){pp0[r], pp0[r + 1]};
#pragma unroll
  for (int r = 0; r < 16; r += 2) ps2 += (f32x2_){pp1[r], pp1[r + 1]};
  float ps = ps2.x + ps2.y;
  { auto rr = __builtin_amdgcn_permlane32_swap(__float_as_uint(ps), __float_as_uint(ps), false, false);
    ps = __uint_as_float(rr[0]) + __uint_as_float(rr[1]); }
  l_reg = l_reg * alp + ps;
  int w[8];
#pragma unroll
  for (int k = 0; k < 4; ++k) { int x = 0; x = __builtin_amdgcn_cvt_pk_fp8_f32(pp0[4 * k], pp0[4 * k + 1], x, false); x = __builtin_amdgcn_cvt_pk_fp8_f32(pp0[4 * k + 2], pp0[4 * k + 3], x, true); w[k] = x;
    int y = 0; y = __builtin_amdgcn_cvt_pk_fp8_f32(pp1[4 * k], pp1[4 * k + 1], y, false); y = __builtin_amdgcn_cvt_pk_fp8_f32(pp1[4 * k + 2], pp1[4 * k + 3], y, true); w[4 + k] = y; }
  P8 = (i32x8){w[0], w[1], w[2], w[3], w[4], w[5], w[6], w[7]};
}
struct AttnUnit {
  const bf16* Q; int ldq;
  const bf16* Kn; int ldkv;
  const bf16* Kr; int ldkr;
  const bf16* V;
  const unsigned char* K8; int ldk8;
  const unsigned char* Kr8;
  const unsigned char* V8; int ldv8;
  bf16* O; int ldo;
  int NT, n0, base0, base1;
  const float* rpb;
  int qrow0, krow0;
};

template <int DQK, int MODE, int K8, int Q8 = 0>
__device__ __forceinline__ void attn_body(const AttnUnit& U, ATT_LAS char* lds, const AttnUnit& N, bool has_next, bool pre) {
  constexpr float SCALE = Sc<DQK>::SCALE; constexpr int NQR = DQK / 16;
  int tid_ = threadIdx.x; asm volatile("" : "+v"(tid_));
  const int tid = tid_, wid = __builtin_amdgcn_readfirstlane(tid >> 6), lane = tid & 63, r32 = lane & 31, hi = lane >> 5;
  ATT_LAS char* V_lds = lds + OFF_V; ATT_LAS char* K_lds = lds + OFF_K; ATT_LAS char* KR_lds = lds + OFF_KR;
  ATT_LAS float* ws = (ATT_LAS float*)(lds + OFF_WS) + wid * 64; ATT_LAS float* li_l = ws; ATT_LAS float* al_l = ws + 32;
  ATT_LAS float* tab = (ATT_LAS float*)(lds + OFF_TAB);
  float m_reg = -1e30f, l_reg = 0; f32x16 o[4] = {}; bf16x8 qr[K8 ? 1 : NQR]; i32x8 q8[DQK / 64];
  if constexpr (K8 && Q8) {
    const unsigned char* Qb = (const unsigned char*)U.Q + (size_t)(wid * QBLK + r32) * U.ldq * 2 + hi * 32;
#pragma unroll
    for (int s = 0; s < DQK / 64; ++s) { const i32x4 lo = *reinterpret_cast<const i32x4*>(Qb + s * 64), hi_ = *reinterpret_cast<const i32x4*>(Qb + s * 64 + 16); q8[s] = __builtin_shufflevector(lo, hi_, 0, 1, 2, 3, 4, 5, 6, 7); }
  } else if constexpr (K8) {
    const bf16* Qw8 = U.Q + (long)(wid * QBLK + r32) * U.ldq + hi * 32;
#pragma unroll
    for (int s = 0; s < DQK / 64; ++s) { int w[8];
#pragma unroll
      for (int j = 0; j < 4; ++j) { const u32x4 x = *reinterpret_cast<const u32x4*>(Qw8 + s * 64 + j * 8);
        int lo = 0, hi_ = 0;
        lo = __builtin_amdgcn_cvt_pk_fp8_f32(__uint_as_float(x.x << 16), __uint_as_float(x.x & 0xffff0000u), lo, false); lo = __builtin_amdgcn_cvt_pk_fp8_f32(__uint_as_float(x.y << 16), __uint_as_float(x.y & 0xffff0000u), lo, true);
        hi_ = __builtin_amdgcn_cvt_pk_fp8_f32(__uint_as_float(x.z << 16), __uint_as_float(x.z & 0xffff0000u), hi_, false); hi_ = __builtin_amdgcn_cvt_pk_fp8_f32(__uint_as_float(x.w << 16), __uint_as_float(x.w & 0xffff0000u), hi_, true);
        w[2 * j] = lo; w[2 * j + 1] = hi_; }
      q8[s] = (i32x8){w[0], w[1], w[2], w[3], w[4], w[5], w[6], w[7]}; }
  } else {
    const bf16* Qw = U.Q + (long)(wid * QBLK + r32) * U.ldq + hi * 8;
#pragma unroll
    for (int d0 = 0; d0 < NQR; ++d0) qr[d0] = *reinterpret_cast<const bf16x8*>(Qw + d0 * 16);
  }
  const ATT_LAS char* Qrs = lds + OFF_OST + wid * 4096;
  const int vb0 = (int)(unsigned)(__UINTPTR_TYPE__)V_lds + v_rd_base(lane);
  const int kRow = tid >> 4, voK = kRow * U.ldkv + (((tid & 15) ^ (kRow & 7)) << 3);
  const int vkk = ((tid >> 7) << 3) + ((tid >> 2) & 7), vk = (vkk & ~0xC) | ((vkk & 4) << 1) | ((vkk & 8) >> 1), voV = vk * U.ldkv + ((tid >> 5) & 3) * 32 + (tid & 3) * 8;
  const int rRow = tid >> 3, voR = rRow * U.ldkr + (((tid & 7) ^ (rRow & 7)) << 3);
  const int voK8 = rRow * U.ldk8 + (((tid & 7) ^ ((rRow >> 1) & 7)) << 4);
  const int r8Row = (tid & 255) >> 2, voR8 = r8Row * 64 + (((tid & 3) ^ ((r8Row >> 2) & 3)) << 4);
  const unsigned wls = (unsigned)wid * 1024u;
  const int vKey = tid >> 3, voV8 = vKey * U.ldv8 + ((((tid & 7) ^ ((vKey & 3) | (((vKey >> 3) & 1) << 2)))) << 4);
  int vb8[4];
  { const int i16 = lane & 15, r_ = i16 >> 1, c_ = i16 & 1, gpar = (lane >> 4) & 1, key0 = 8 * (r_ >> 2) + 4 * hi + (r_ & 3);
#pragma unroll
    for (int d0 = 0; d0 < 4; ++d0) vb8[d0] = (int)(unsigned)(__UINTPTR_TYPE__)V_lds + key0 * 128 + (((2 * d0 + gpar) ^ r_) << 4) + 8 * c_; }
  int na_qrow = 0, na_rs = 0, na_lo = 0, na_tb = 0;
  if constexpr (MODE == 1) {
    for (int i = tid; i < 15 * 128; i += 512) { const int dr = i >> 7, x = (i & 127) - 48; tab[i] = (x >= 0 && x < 31) ? U.rpb[dr * 31 + x] * (1.0f / SCALE) : 0.f; }
    na_qrow = U.qrow0 + (wid >> 1);
    const int c = 32 * (wid & 1) + r32; int cs = c - 8; cs = cs < 0 ? 0 : (cs > 48 ? 48 : cs);
    na_rs = na_qrow - 4; na_rs = na_rs < 0 ? 0 : (na_rs > 24 ? 24 : na_rs);
    na_lo = cs - 4 * hi;
    na_tb = 63 - c + 4 * hi;
  }
  auto krow = [&](int j) -> long { return (j < U.n0) ? (long)U.base0 + 64 * j : (long)U.base1 + 64 * (j - U.n0); };
#define DMA16(g, l) __builtin_amdgcn_global_load_lds((const unsigned*)(g), (ATT_LAS unsigned*)(l), 16, 0, 0)
#define ISSUE_K(j, b) do { const long _k0 = krow(j); if constexpr (K8) { DMA16(U.K8 + _k0 * U.ldk8 + voK8, K_lds + (b) * SHM_K + wls); if constexpr (DQK == 192) DMA16(U.Kr8 + _k0 * 64 + voR8, KR_lds + (b) * SHM_KR + (wls & 3072u)); } else { const bf16* _kp = U.Kn + _k0 * U.ldkv; \
    DMA16(_kp + voK, K_lds + (b) * SHM_K + wls); DMA16(_kp + 32 * U.ldkv + voK, K_lds + (b) * SHM_K + wls + 8192); } \
    if constexpr (DQK == 192 && !K8) { const bf16* _rp = U.Kr + _k0 * U.ldkr; DMA16(_rp + voR, KR_lds + (b) * SHM_KR + wls); } } while (0)
#define ISSUE_V(j, b) do { const long _k0 = krow(j); if constexpr (K8) { DMA16(U.V8 + _k0 * U.ldv8 + voV8, V_lds + (b) * SHM_V + wls); } else { const bf16* _vp = U.V + _k0 * U.ldkv; \
    DMA16(_vp + voV, V_lds + (b) * SHM_V + wls); DMA16(_vp + 32 * U.ldkv + voV, V_lds + (b) * SHM_V + wls + 8192); } } while (0)
#define WAITNV() do { if constexpr (K8) WAITV(1); else WAITV(2); } while (0)
#define WAITV(n) asm volatile("s_waitcnt vmcnt(" #n ")" ::: "memory")
#define BAR() do { asm volatile("" ::: "memory"); __builtin_amdgcn_s_barrier(); asm volatile("" ::: "memory"); } while (0)
#define RESC(a) do { if (__any((a) < 1.f)) { if (hi == 0) al_l[r32] = (a); asm volatile("s_waitcnt lgkmcnt(0)" ::: "memory"); \
    asm volatile("s_nop 15\n\ts_nop 7" : "+v"(o[0]), "+v"(o[1]), "+v"(o[2]), "+v"(o[3]));        \
    _Pragma("unroll") for (int d = 0; d < 4; ++d) _Pragma("unroll") for (int r = 0; r < 16; ++r) o[d][r] *= al_l[crow(r, hi)]; } } while (0)
#define NAHOOK(P0, P1, j) do { if constexpr (MODE == 1) { if ((j) >= U.n0) { \
      const int _kr = U.krow0 + ((j) - U.n0); const bool _rv = (_kr >= na_rs) && (_kr < na_rs + 8); \
      int _dr = _kr - na_qrow + 7; _dr = _dr < 0 ? 0 : (_dr > 14 ? 14 : _dr); \
      const ATT_LAS float* _t = tab + _dr * 128 + na_tb; \
      _Pragma("unroll") for (int r = 0; r < 16; ++r) { const int kc0 = (r & 3) + 8 * (r >> 2); \
        const bool v0 = _rv && ((unsigned)(kc0 - na_lo) < 16u); const bool v1 = _rv && ((unsigned)(kc0 + 32 - na_lo) < 16u); \
        P0[r] = v0 ? P0[r] + _t[kc0] : -1e30f; P1[r] = v1 ? P1[r] + _t[kc0 + 32] : -1e30f; } } } } while (0)
  f32x16 pA0, pA1, pB0, pB1; float mnA = 0.f, mnB = 0.f, alA = 1.f, alB = 1.f; bf16x8 pa0, pa1, pa2, pa3; i32x8 P8; const int NT = U.NT;
  auto live = [&](int j) -> bool { if constexpr (MODE == 1) { if (j >= U.n0) { const int kr_ = U.krow0 + (j - U.n0); return (kr_ >= na_rs) && (kr_ < na_rs + 8); } } return true; };
#define QKT(P0, P1, KB, KRB) do { if constexpr (K8) qkt8<DQK>(P0, P1, KB, KRB, q8, r32, hi); else qkt<DQK>(P0, P1, KB, KRB, qr, Qrs, r32, hi); } while (0)
#define FINPV(PP0, PP1, ALP, VB) do { if constexpr (K8) { finishSM8(PP0, PP1, ALP, l_reg, P8); SBAR(); pv8(o, vb8, (VB) - vb0, P8); } else { finishSM(PP0, PP1, ALP, l_reg, pa0, pa1, pa2, pa3); SBAR(); pv_d0(o, VB, pa0, pa1, pa2, pa3); } } while (0)
#define TRBLK(X, D0, VBO) const u32x2 X##0 = tr8_read<0>(vb8[D0] + (VBO)), X##1 = tr8_read<2048>(vb8[D0] + (VBO)), X##2 = tr8_read<4096>(vb8[D0] + (VBO)), X##3 = tr8_read<6144>(vb8[D0] + (VBO))
#define TRVF(X) (i32x8){(int)(X##0).x, (int)(X##0).y, (int)(X##1).x, (int)(X##1).y, (int)(X##2).x, (int)(X##2).y, (int)(X##3).x, (int)(X##3).y}
#define FUSED_B(PS0, PS1, js, MNS, ALS, VBO) do { const int one = 0x7F7F7F7F; constexpr float C_ = SCALE * 1.4426950408889634f; \
    TRBLK(x_, 0, VBO); TRBLK(y_, 1, VBO); asm volatile("s_waitcnt lgkmcnt(4)" ::: "memory"); \
    { const i32x8 vf = TRVF(x_); ATT_MF2(o[0], P8, vf, PS0, PS1); } \
    NAHOOK(PS0, PS1, js); \
    float pmax_ = PS0[0]; \
    _Pragma("unroll") for (int r = 1; r < 16; ++r) pmax_ = fmaxf(pmax_, PS0[r]); \
    _Pragma("unroll") for (int r = 0; r < 16; ++r) pmax_ = fmaxf(pmax_, PS1[r]); \
    { auto rr = __builtin_amdgcn_permlane32_swap(__float_as_uint(pmax_), __float_as_uint(pmax_), false, false); pmax_ = fmaxf(__uint_as_float(rr[0]), __uint_as_float(rr[1])); } \
    if (__builtin_expect(__all(pmax_ - m_reg <= 3.f / SCALE), 1)) { MNS = m_reg; ALS = 1.f; } \
    else { MNS = fmaxf(m_reg, pmax_); ALS = __builtin_amdgcn_exp2f((m_reg - MNS) * C_); m_reg = MNS; } \
    const float mnC_ = -MNS * C_ + 4.f; \
    TRBLK(z_, 2, VBO); asm volatile("s_waitcnt lgkmcnt(4)" ::: "memory"); \
    { const i32x8 vf = TRVF(y_); ATT_MF2(o[1], P8, vf, PS0, PS1); } \
    _Pragma("unroll") for (int r = 0; r < 16; ++r) PS0[r] = fmaf(PS0[r], C_, mnC_); \
    _Pragma("unroll") for (int r = 0; r < 16; ++r) PS1[r] = fmaf(PS1[r], C_, mnC_); \
    TRBLK(u_, 3, VBO); asm volatile("s_waitcnt lgkmcnt(4)" ::: "memory"); \
    { const i32x8 vf = TRVF(z_); ATT_MF2(o[2], P8, vf, PS0, PS1); } \
    exp_rng<0, 4>(PS0); \
    asm volatile("s_waitcnt lgkmcnt(0)" ::: "memory"); \
    { const i32x8 vf = TRVF(u_); ATT_MF2(o[3], P8, vf, PS0, PS1); } \
    exp_rng<4, 16>(PS0); } while (0)
#define HALF_STEP(PS0, PS1, KB, KRB, js, MNS, ALS, PP0, PP1, ALP, VB, jp) do { const bool ls_ = live(js), lp_ = live(jp); bool fz_ = false; if constexpr (K8 && MODE == 0) fz_ = ls_ && lp_; \
    if (fz_) { if constexpr (K8 && MODE == 0) { SBAR(); fusedA<DQK>(PS0, PS1, KB, KRB, q8, r32, hi, PP0, PP1, ALP, l_reg, P8); FUSED_B(PS0, PS1, js, MNS, ALS, (VB) - vb0); } } \
    else { \
    if (ls_) { SBAR(); QKT(PS0, PS1, KB, KRB); } \
    if (lp_) { FINPV(PP0, PP1, ALP, VB); } \
    if (ls_) { NAHOOK(PS0, PS1, js); partialSM<DQK, K8>(PS0, PS1, m_reg, MNS, ALS); } else { ALS = 1.f; } } } while (0)
  WAITV(0);
  if (!pre) { ISSUE_K(0, 0); ISSUE_V(0, 0); ISSUE_K(1, 1);
    if constexpr (K8) { if constexpr (DQK == 192) WAITV(2); else WAITV(1); } else { if constexpr (DQK == 192) WAITV(3); else WAITV(2); } }
  asm volatile("s_waitcnt lgkmcnt(0)" ::: "memory"); BAR();
  QKT(pA0, pA1, K_lds, KR_lds); NAHOOK(pA0, pA1, 0); partialSM<DQK, K8>(pA0, pA1, m_reg, mnA, alA);
  ISSUE_V(1, 1);
  WAITNV(); BAR();
  for (int j = 1; j + 1 < NT; j += 2) {
    ISSUE_K(j + 1, 0);
    HALF_STEP(pB0, pB1, K_lds + SHM_K, KR_lds + SHM_KR, j, mnB, alB, pA0, pA1, alA, vb0, j - 1);
    BAR();
    ISSUE_V(j + 1, 0);
    RESC(alB);
    WAITNV(); BAR();
    ISSUE_K(j + 2, 1);
    HALF_STEP(pA0, pA1, K_lds, KR_lds, j + 1, mnA, alA, pB0, pB1, alB, vb0 + SHM_V, j);
    BAR();
    ISSUE_V(j + 2, 1);
    RESC(alA);
    WAITNV(); BAR();
  }
  HALF_STEP(pB0, pB1, K_lds + SHM_K, KR_lds + SHM_KR, NT - 1, mnB, alB, pA0, pA1, alA, vb0, NT - 2);
  RESC(alB);
  WAITV(0); BAR();
  if constexpr (K8) { if (has_next) {
      const int nK = rRow * N.ldk8 + (((tid & 7) ^ ((rRow >> 1) & 7)) << 4), nV = vKey * N.ldv8 + ((((tid & 7) ^ ((vKey & 3) | (((vKey >> 3) & 1) << 2)))) << 4);
      const long k0_ = (0 < N.n0) ? (long)N.base0 : (long)N.base1, k1_ = (1 < N.n0) ? (long)N.base0 + 64 : (long)N.base1 + 64 * (1 - N.n0);
      DMA16(N.K8 + k0_ * N.ldk8 + nK, K_lds + wls); if constexpr (DQK == 192) DMA16(N.Kr8 + k0_ * 64 + voR8, KR_lds + (wls & 3072u));
      DMA16(N.V8 + k0_ * N.ldv8 + nV, V_lds + wls);
      DMA16(N.K8 + k1_ * N.ldk8 + nK, K_lds + SHM_K + wls); if constexpr (DQK == 192) DMA16(N.Kr8 + k1_ * 64 + voR8, KR_lds + SHM_KR + (wls & 3072u)); } }
  if (live(NT - 1)) { FINPV(pB0, pB1, alB, vb0 + SHM_V); }
  int le_ = lane; asm volatile("" : "+v"(le_)); const int r32e = le_ & 31, hie = le_ >> 5;
  if (hie == 0) li_l[r32e] = l_reg; asm volatile("s_waitcnt lgkmcnt(0)" ::: "memory");
  float rli[16];
#pragma unroll
  for (int r = 0; r < 16; ++r) rli[r] = __builtin_amdgcn_rcpf(li_l[crow(r, hie)]) * YS;
  { ATT_LAS unsigned char* st = (ATT_LAS unsigned char*)(lds + OFF_OST) + wid * 4096;
#pragma unroll
    for (int r = 0; r < 16; ++r) { const int orow = crow(r, hie);
#pragma unroll
      for (int d0 = 0; d0 < 4; ++d0) { const int w = __builtin_amdgcn_cvt_pk_fp8_f32(o[d0][r] * rli[r], 0.f, 0, false); st[orow * 128 + d0 * 32 + r32e] = (unsigned char)w; } }
    asm volatile("s_waitcnt lgkmcnt(0)" ::: "memory");
    unsigned char* Ob = (unsigned char*)U.O + (size_t)(wid * QBLK) * U.ldo * 2 + (le_ & 7) * 16;
#pragma unroll
    for (int i = 0; i < 4; ++i) { const int row = (le_ >> 3) + 8 * i; const u32x4 w = *(const ATT_LAS u32x4*)(st + row * 128 + (le_ & 7) * 16);
      *(u32x4*)(Ob + (size_t)row * U.ldo * 2) = w; }
    asm volatile("s_waitcnt lgkmcnt(0)" ::: "memory"); }
  BAR();
#undef HALF_STEP
#undef FUSED_B
#undef TRBLK
#undef TRVF
#undef FINPV
#undef WAITNV
#undef QKT
#undef DMA16
#undef ISSUE_K
#undef ISSUE_V
#undef WAITV
#undef BAR
#undef RESC
#undef NAHOOK
}
}
constexpr int NB = 8, SEQ = 2048, CTXL = 256, D = 2048, TPB = SEQ + CTXL  , M = NB * TPB  ;
constexpr int DEPTH = 2;
constexpr int N_IN = 19008, NP = 19200  , LDP = 21248  , C_YA = 19200;
constexpr int C_MQ = 0, C_CKV = 3072, C_KR = 3584, C_NQ = 3648, C_NK = 5696, C_NV = 7744, C_GQ = 9792, C_GK = 11840, C_GV = 12352, C_GATE = 12864;
constexpr int KVR = 512, KVW = 4096, DFF = 5632, DFF2 = 11264, ADA = 12288;
constexpr float ALPHA = 1.4142135623730951f, ADA_EPS = 1e-6f, POST_EPS = 1e-5f, RMS_EPS = 1e-6f;
constexpr size_t MiB = 1u << 20;
constexpr size_t WS_CTL = 0, CTL_ZERO_BYTES = 64 * 1024;
constexpr size_t WS_MFIN = 1 * MiB, WS_MPART = 2 * MiB, WS_XCTX = 16 * MiB, WS_C = 32 * MiB, WS_KRR = 50 * MiB;
constexpr size_t WS_WIN = 53 * MiB, WS_WUKV = 128 * MiB, WS_WBR = 132 * MiB, WS_WOUT = 156 * MiB, WS_WUP = 164 * MiB, WS_WDN = 208 * MiB;
constexpr size_t WS_KV = 230 * MiB, WS_P = 374 * MiB, WS_KN8 = 1121 * MiB  , WS_END = 1157 * MiB;
constexpr size_t WS_KM8 = WS_KV  , WS_VM8 = WS_KV + 36 * MiB  , WS_VN8 = WS_KV + 72 * MiB  , WS_VG8 = WS_KV + 108 * MiB  ;
constexpr size_t WS_KG8 = WS_MPART;
constexpr size_t WS_ACC = WS_KV, WS_ACC8 = WS_KV + 72 * MiB  , WS_H2 = WS_KV + 72 * MiB, WS_FOUT = WS_KV;
constexpr size_t WS_YOUT = WS_P, WS_SBG = WS_P  , WS_SBV = WS_P + 16 * MiB  , WS_A = WS_P + 396 * MiB;
static_assert(WS_WIN + (size_t)NP * D * 2 <= WS_WUKV && WS_KV + (size_t)M * KVW * 2 <= WS_P && WS_P + (size_t)M * LDP * 2 <= WS_KN8 && WS_KN8 + (size_t)M * 2048 <= WS_END && WS_KG8 + (size_t)M * 512 <= WS_XCTX && WS_A + (size_t)M * DFF * 2 <= WS_END && (size_t)M * DFF2 * 2 <= 396 * MiB, "ws map");
constexpr int CW_BAR = 4096;
constexpr int RING_BYTES = 131072, LDSCTL_OFF = RING_BYTES, MISC_OFF = LDSCTL_OFF + 320, LDS_BYTES = 147456;
constexpr int NWAVES = 8;

#define GAS __attribute__((address_space(1)))
#define LAS __attribute__((address_space(3)))
typedef unsigned short bf16;
typedef unsigned v4u __attribute__((ext_vector_type(4)));
typedef unsigned v2u __attribute__((ext_vector_type(2)));
typedef float f32x4 __attribute__((ext_vector_type(4)));
#define LDS_WAIT() asm volatile("s_waitcnt lgkmcnt(0)" ::: "memory")
__device__ __forceinline__ unsigned f2bf(float f) { unsigned u = __builtin_bit_cast(unsigned, f); return (u + 0x7fffu + ((u >> 16) & 1u)) >> 16; }
__device__ __forceinline__ unsigned pk2(float lo, float hi) { return f2bf(lo) | (f2bf(hi) << 16); }
__device__ __forceinline__ float bf2f(unsigned short b) { return __uint_as_float(((unsigned)b) << 16); }
__device__ __forceinline__ float wave_sum(float v) {
#pragma unroll
    for (int o = 1; o < 64; o <<= 1) v += __shfl_xor(v, o);
    return v;
}

#define XB_TMO      128
#define XB_XCNT(j)  (256  + 64 * (j))
#define XB_XSUB(j)  (1280 + 64 * (j))
#define XB_XGEN(j)  (2304 + 64 * (j))
#define XB_TOP      3328
#define XB_TOPGEN   3392
#define XCD_BAR_WORDS 3456
#define XB_SPIN_CAP (1u << 18)
__device__ __forceinline__ unsigned xb_ld(unsigned* p)              { return __hip_atomic_load(p, __ATOMIC_RELAXED, __HIP_MEMORY_SCOPE_AGENT); }
__device__ __forceinline__ unsigned xb_add(unsigned* p, unsigned v) { return __hip_atomic_fetch_add(p, v, __ATOMIC_RELAXED, __HIP_MEMORY_SCOPE_AGENT); }
__device__ __forceinline__ unsigned xb_xcc_id() { return (unsigned)__builtin_amdgcn_s_getreg((3 << 11) | 20) & 0xFu; }
#define XB_SPIN(cond, bar) do { unsigned _sp = 0; while (cond) { __builtin_amdgcn_s_sleep(1); \
    if ((++_sp & 255u) == 0u) { if (xb_ld(&(bar)[XB_TMO])) break; if (_sp > XB_SPIN_CAP) { atomicAdd(&(bar)[XB_TMO], 1u); break; } } } } while (0)
struct XcdBarrier { unsigned* bar; unsigned x; volatile LAS unsigned* st; };
__device__ __forceinline__ XcdBarrier xcd_barrier_post(unsigned* bar, volatile LAS unsigned* st) {
    XcdBarrier b; b.bar = bar; b.x = xb_xcc_id(); b.st = st;
    if (threadIdx.x == 0) (void)xb_add(&bar[XB_XCNT(b.x)], 1u);
    return b;
}
__device__ __forceinline__ void xcd_barrier_complete(unsigned* bar, unsigned x, unsigned& nloc, unsigned& nx) {
    const unsigned G = gridDim.x * gridDim.y * gridDim.z;
    unsigned sum, cnt, mine, sp = 0u;
    for (;;) {
        sum = 0u; cnt = 0u; mine = 0u;
#pragma unroll
        for (unsigned j = 0; j < 16; ++j) { const unsigned c = xb_ld(&bar[XB_XCNT(j)]); sum += c; cnt += (c > 0u) ? 1u : 0u; mine = (j == x) ? c : mine; }
        if (sum == G) break;
        __builtin_amdgcn_s_sleep(1);
        if ((++sp & 255u) == 0u) { if (xb_ld(&bar[XB_TMO])) break; if (sp > XB_SPIN_CAP) { atomicAdd(&bar[XB_TMO], 1u); break; } }
    }
    nloc = mine > 0u ? mine : 1u; nx = cnt > 0u ? cnt : 1u;
}
__device__ __forceinline__ void xcd_barrier(const XcdBarrier& b) {
    asm volatile("s_waitcnt vmcnt(0)" ::: "memory");
    __syncthreads();
    if (threadIdx.x == 0) {
        unsigned* bar = b.bar;
        __builtin_amdgcn_s_waitcnt(0);
        unsigned nloc = b.st[0], nx = b.st[1];
        if (nloc == 0u) { xcd_barrier_complete(bar, b.x, nloc, nx); b.st[0] = nloc; b.st[1] = nx; }
        const unsigned old = xb_add(&bar[XB_XSUB(b.x)], 1u);
        const unsigned gen = old / nloc;
        if (old + 1u == (gen + 1u) * nloc) {
            __builtin_amdgcn_fence(__ATOMIC_RELEASE, "agent");
            asm volatile("s_waitcnt vmcnt(0)" ::: "memory");
            const unsigned og = xb_add(&bar[XB_TOP], 1u);
            const unsigned tg = og / nx;
            if (og + 1u == (tg + 1u) * nx) xb_add(&bar[XB_TOPGEN], 1u);
            else XB_SPIN(xb_ld(&bar[XB_TOPGEN]) == tg, bar);
            __builtin_amdgcn_fence(__ATOMIC_ACQUIRE, "agent");
            xb_add(&bar[XB_XGEN(b.x)], 1u);
            asm volatile("s_waitcnt vmcnt(0)" ::: "memory");
        } else {
            XB_SPIN(xb_ld(&bar[XB_XGEN(b.x)]) == gen, bar);
            __builtin_amdgcn_fence(__ATOMIC_ACQUIRE, "agent");
            asm volatile("s_waitcnt vmcnt(0)" ::: "memory");
        }
    }
    __syncthreads();
}

struct Args { const float* in[22]; float* out; unsigned char* ws; };
enum { I_X = 0, I_C, I_CTX, I_CCTX, I_WADA, I_BADA, I_WIN, I_KVNORM, I_WUKV, I_QNORM, I_KNORM, I_RPB, I_WBR, I_WOUT, I_LNAG, I_LNAB, I_WUP, I_CONVW, I_CONVB, I_WDOWN, I_LNFG, I_LNFB };
struct Frame { LAS unsigned char* lds; int tid, lane, wave, G, vcu; };
constexpr int PTAB_OFF = LDSCTL_OFF + 512;
__device__ __forceinline__ unsigned long long ptab_get(const Frame& F, int i) {
    volatile LAS unsigned* t = (volatile LAS unsigned*)(F.lds + PTAB_OFF) + 2 * i;
    const unsigned lo = __builtin_amdgcn_readfirstlane(t[0]), hi = __builtin_amdgcn_readfirstlane(t[1]);
    return ((unsigned long long)hi << 32) | lo;
}
__device__ __forceinline__ const float* in_ptr(const Frame& F, int i) { return (const float*)(const GAS float*)ptab_get(F, i); }
__device__ __forceinline__ float* out_ptr(const Frame& F) { return (float*)(GAS float*)ptab_get(F, 22); }
__device__ __forceinline__ unsigned char* ws_ptr(const Frame& F) { return (unsigned char*)(GAS unsigned char*)ptab_get(F, 23); }
__device__ __forceinline__ int opq_v(int x) { asm volatile("" : "+v"(x)); return x; }
__device__ __forceinline__ int opq_s(int x) { asm volatile("" : "+s"(x)); return x; }
__device__ __forceinline__ LAS unsigned char* opq_l(LAS unsigned char* p) { unsigned v = (unsigned)(__UINTPTR_TYPE__)p; asm volatile("" : "+s"(v)); return (LAS unsigned char*)(__UINTPTR_TYPE__)v; }
__device__ __forceinline__ Frame fresh(const Frame& F0) { Frame F; F.lds = opq_l(F0.lds); F.tid = opq_v(F0.tid); F.lane = F.tid & 63; F.wave = __builtin_amdgcn_readfirstlane(F.tid >> 6); F.G = opq_s(F0.G); F.vcu = opq_s(F0.vcu); return F; }

template <bool PAIR = false>
__device__ __forceinline__ void transpose_item(const float* W, int K, int N, bf16* WT, LAS float* scr, int item, int lane) {
    const int nblk = N / 32, kb = item / nblk, nb = item % nblk, k0 = 64 * kb, n0 = 32 * nb;
    int d0 = n0; if (PAIR) { const int h = N / 2, cc = n0 >= h ? n0 - h : n0; d0 = (cc >> 7) * 256 + (n0 >= h ? 128 : 0) + (cc & 127); }
    float t[32];
#pragma unroll
    for (int i = 0; i < 32; ++i) { const int kk = 2 * i + (lane >> 5); t[i] = __builtin_nontemporal_load(W + (size_t)(k0 + kk) * N + n0 + (lane & 31)); }
#pragma unroll
    for (int i = 0; i < 32; ++i) { const int kk = 2 * i + (lane >> 5); scr[kk * 33 + (lane & 31)] = t[i]; }
    LDS_WAIT(); asm volatile("" ::: "memory");
    const int c = lane & 7;
#pragma unroll
    for (int j = 0; j < 4; ++j) { const int n = (lane >> 3) + 8 * j; const LAS float* s = scr + (8 * c) * 33 + n;
        v4u o; o.x = pk2(s[0 * 33], s[1 * 33]); o.y = pk2(s[2 * 33], s[3 * 33]); o.z = pk2(s[4 * 33], s[5 * 33]); o.w = pk2(s[6 * 33], s[7 * 33]);
        *(v4u*)(WT + (size_t)(d0 + n) * K + k0 + 8 * c) = o; }
    LDS_WAIT(); asm volatile("" ::: "memory");
}
constexpr float W8_SCALE = 64.0f, WB_SCALE = 128.0f, ACC_SCALE = 16.0f, WKV_SCALE = 32.0f;
__device__ __forceinline__ unsigned pk4_fp8(float a, float b, float c, float d) { int w = 0; w = __builtin_amdgcn_cvt_pk_fp8_f32(a, b, w, false); w = __builtin_amdgcn_cvt_pk_fp8_f32(c, d, w, true); return (unsigned)w; }
template <bool REMAP = false>
__device__ __forceinline__ void transpose_item_fp8(const float* W, int K, int N, unsigned char* WT, LAS float* scr, int item, int lane, float wscale) {
    const int nblk = N / 32, kb = item / nblk, nb = item % nblk, k0 = 64 * kb, n0 = 32 * nb;
    int d0 = n0; if (REMAP) { const int g = (n0 >> 5) & 7; d0 = (n0 & ~255) + (((g & 1) << 2) + (g >> 1)) * 32; }
    float t[32];
#pragma unroll
    for (int i = 0; i < 32; ++i) { const int kk = 2 * i + (lane >> 5); t[i] = __builtin_nontemporal_load(W + (size_t)(k0 + kk) * N + n0 + (lane & 31)); }
#pragma unroll
    for (int i = 0; i < 32; ++i) { const int kk = 2 * i + (lane >> 5); scr[kk * 33 + (lane & 31)] = t[i] * wscale; }
    LDS_WAIT(); asm volatile("" ::: "memory");
    const int c = lane & 7;
#pragma unroll
    for (int j = 0; j < 4; ++j) { const int n = (lane >> 3) + 8 * j; const LAS float* s = scr + (8 * c) * 33 + n;
        v2u o; o.x = pk4_fp8(s[0 * 33], s[1 * 33], s[2 * 33], s[3 * 33]); o.y = pk4_fp8(s[4 * 33], s[5 * 33], s[6 * 33], s[7 * 33]);
        *(v2u*)(WT + (size_t)(d0 + n) * K + k0 + 8 * c) = o; }
    LDS_WAIT(); asm volatile("" ::: "memory");
}
__device__ __forceinline__ void convert_weights(const Frame& F0, int l) {
    const Frame F = fresh(F0);
    LAS float* scr = (LAS float*)(F.lds + F.wave * 16384);
    const int gw = F.vcu * NWAVES + F.wave, NGW = F.G * NWAVES;
    constexpr int I_IN = (D / 64) * (N_IN / 32), I_UKV = (KVR / 64) * (KVW / 32), I_BR = (D / 64) * (D / 32), I_OUT = I_BR, I_UP = (D / 64) * (DFF2 / 32), I_DN = (DFF / 64) * (D / 32);
    constexpr int NITEMS = I_IN + I_UKV + 3 * I_BR + I_OUT + I_UP + I_DN;
    unsigned char* ws = ws_ptr(F);
    const float* w_in = in_ptr(F, I_WIN); const float* w_ukv = in_ptr(F, I_WUKV); const float* w_br = in_ptr(F, I_WBR); const float* w_out = in_ptr(F, I_WOUT); const float* w_up = in_ptr(F, I_WUP); const float* w_dn = in_ptr(F, I_WDOWN);
    for (int it = gw; it < NITEMS; it += NGW) {
        int r = it;
        if (r < I_IN) { transpose_item_fp8<true>(w_in + (size_t)l * D * N_IN, D, N_IN, (unsigned char*)(ws + WS_WIN), scr, r, F.lane, W8_SCALE); continue; } r -= I_IN;
        if (r < I_UKV) { transpose_item_fp8(w_ukv + (size_t)l * KVR * KVW, KVR, KVW, (unsigned char*)(ws + WS_WUKV), scr, r, F.lane, WKV_SCALE); continue; } r -= I_UKV;
        if (r < 3 * I_BR) { const int i = r / I_BR; transpose_item_fp8(w_br + (size_t)(l * 3 + i) * D * D, D, D, (unsigned char*)(ws + WS_WBR) + (size_t)i * D * D, scr, r % I_BR, F.lane, WB_SCALE); continue; } r -= 3 * I_BR;
        if (r < I_OUT) { transpose_item_fp8(w_out + (size_t)l * D * D, D, D, (unsigned char*)(ws + WS_WOUT), scr, r, F.lane, WB_SCALE); continue; } r -= I_OUT;
        if (r < I_UP) { transpose_item<true>(w_up + (size_t)l * D * DFF2, D, DFF2, (bf16*)(ws + WS_WUP), scr, r, F.lane); continue; } r -= I_UP;
        transpose_item(w_dn + (size_t)l * DFF * D, DFF, D, (bf16*)(ws + WS_WDN), scr, r, F.lane);
    }
    { constexpr int per = 32 * D / 16, nz = (NP - N_IN) / 32 * per;
      for (int i = F.vcu * 512 + F.tid; i < nz; i += F.G * 512) { const int g = (N_IN % 256) / 32 + i / per, gp = ((g & 1) << 2) + (g >> 1);
          ((v4u*)(ws + WS_WIN + (size_t)((N_IN & ~255) + gp * 32) * D))[i % per] = (v4u){0u, 0u, 0u, 0u}; } }
}
__device__ __forceinline__ void adaln_partial(const Frame& F0) {
    const Frame F = fresh(F0);
    LAS float* sc = (LAS float*)F.lds;
    float* MPART = (float*)(ws_ptr(F) + WS_MPART);
    const float* cin = in_ptr(F, I_C); const float* cctx = in_ptr(F, I_CCTX); const float* wada = in_ptr(F, I_WADA);
    for (int item = F.vcu; item < 768; item += F.G) {
        const int l = item / 384, rem = item % 384, chunk = rem >> 4, s = rem & 15;
        __syncthreads();
        for (int idx = F.tid; idx < 9 * 128; idx += 512) { const int bi = idx >> 7, k = idx & 127; const float v = bi < 8 ? cin[bi * D + s * 128 + k] : cctx[s * 128 + k]; sc[idx] = v / (1.0f + expf(-v)); }
        __syncthreads();
        const int j = chunk * 512 + F.tid;
        const float* W = wada + ((size_t)l * D + s * 128) * ADA + j;
        float acc[9];
#pragma unroll
        for (int bi = 0; bi < 9; ++bi) acc[bi] = 0.f;
        for (int k = 0; k < 128; k += 32) {
            float w[32];
#pragma unroll
            for (int kk = 0; kk < 32; ++kk) w[kk] = __builtin_nontemporal_load(W + (size_t)(k + kk) * ADA);
#pragma unroll
            for (int kk = 0; kk < 32; ++kk)
#pragma unroll
                for (int bi = 0; bi < 9; ++bi) acc[bi] = fmaf(sc[bi * 128 + k + kk], w[kk], acc[bi]);
        }
#pragma unroll
        for (int bi = 0; bi < 9; ++bi) MPART[((size_t)(l * 16 + s) * 9 + bi) * ADA + j] = acc[bi];
    }
    __syncthreads();
}
__device__ __forceinline__ void adaln_final(const Frame& F0) {
    const Frame F = fresh(F0);
    unsigned char* ws = ws_ptr(F); const float* bada = in_ptr(F, I_BADA);
    const float* MPART = (const float*)(ws + WS_MPART); float* MFIN = (float*)(ws + WS_MFIN);
    for (int idx = F.vcu * 512 + F.tid; idx < DEPTH * 9 * ADA; idx += F.G * 512) {
        const int l = idx / (9 * ADA), rem = idx % (9 * ADA), bi = rem / ADA, j = rem % ADA;
        float s = bada[l * ADA + j];
#pragma unroll
        for (int k = 0; k < 16; ++k) s += MPART[((size_t)(l * 16 + k) * 9 + bi) * ADA + j];
        MFIN[idx] = s;
    }
}

__device__ __forceinline__ void ln_inplace(f32x4 (&v)[8], float eps) {
    float s = 0.f;
#pragma unroll
    for (int j = 0; j < 8; ++j) s += (v[j].x + v[j].y) + (v[j].z + v[j].w);
    const float mean = wave_sum(s) * (1.f / D); float s2 = 0.f;
#pragma unroll
    for (int j = 0; j < 8; ++j) { v[j] = v[j] - mean; s2 += (v[j].x * v[j].x + v[j].y * v[j].y) + (v[j].z * v[j].z + v[j].w * v[j].w); }
    const float rstd = 1.f / sqrtf(wave_sum(s2) * (1.f / D) + eps);
#pragma unroll
    for (int j = 0; j < 8; ++j) v[j] = v[j] * rstd;
}
template <int KIND>
__device__ __forceinline__ void row_phase(const Frame& F0, int l, bool poison) {
    const Frame F = fresh(F0);
    unsigned char* ws = ws_ptr(F); float* outp = out_ptr(F); const float* xin = in_ptr(F, I_X); const float* ctxin = in_ptr(F, I_CTX);
    const float* lng = in_ptr(F, KIND == 1 ? I_LNAG : I_LNFG) + (size_t)l * D; const float* lnb = in_ptr(F, KIND == 1 ? I_LNAB : I_LNFB) + (size_t)l * D;
    const float* MFIN = (const float*)(ws + WS_MFIN);
    const bool last = (l == DEPTH - 1);
    const bool want_h = !(KIND == 2 && last);
    const int lm = (KIND == 2) ? l + 1 : l;
    LAS f32x4* LG = (LAS f32x4*)F.lds; LAS f32x4* LB = LG + 512; LAS f32x4* SETS = LG + 1024;
    const bool from_input = (KIND == 0) || (KIND == 1 && l == 0);
    for (int chunk = F.vcu; chunk < M / 72; chunk += F.G) {
        const int row_a = chunk * 72, row_b = row_a + 71;
        const int bA = row_a / TPB, bB = row_b / TPB; const int biA = (row_a - bA * TPB >= SEQ) ? 8 : bA, biB = (row_b - bB * TPB >= SEQ) ? 8 : bB;
        __syncthreads();
        { const int t = F.tid;
          if (KIND != 0) { LG[t] = ((const f32x4*)lng)[t]; LB[t] = ((const f32x4*)lnb)[t]; }
#pragma unroll
          for (int s_ = 0; s_ < 2; ++s_) { const int bi = s_ ? biB : biA;
              if (KIND != 0) SETS[s_ * 1536 + t] = ((const f32x4*)(MFIN + ((size_t)(l * 9 + bi) * 6 + (KIND == 1 ? 2 : 5)) * D))[t];
              if (want_h) { const float* sh = MFIN + ((size_t)(lm * 9 + bi) * 6 + (KIND == 1 ? 3 : 0)) * D; SETS[s_ * 1536 + 512 + t] = ((const f32x4*)sh)[t]; SETS[s_ * 1536 + 1024 + t] = ((const f32x4*)(sh + D))[t]; } } }
        __syncthreads();
        const int r0 = row_a + F.wave * 9;
        f32x4 xa[8], xb[8]; v2u ya[8], yb[8];
#define ROW_INFO(r, b_, i_, isctx_, skip_) const int b_ = (r) / TPB, i_ = (r) - b_ * TPB; const bool isctx_ = i_ >= SEQ; const bool skip_ = (KIND != 0 && last && isctx_)
#define ROW_XPTRS(b_, i_, isctx_, xsrc_, xdst_) float* xdst_ = isctx_ ? (float*)(ws + WS_XCTX) + (size_t)(b_ * CTXL + i_ - SEQ) * D : outp + (size_t)(b_ * SEQ + i_) * D; \
        const float* xsrc_ = from_input ? (isctx_ ? ctxin + (size_t)(b_ * CTXL + i_ - SEQ) * D : xin + (size_t)(b_ * SEQ + i_) * D) : xdst_
#define ROW_LOAD(r, X, Y) do { ROW_INFO(r, b_, i_, c_, sk_); if (!sk_) { ROW_XPTRS(b_, i_, c_, xs_, xd_); (void)xd_; \
        _Pragma("unroll") for (int j = 0; j < 8; ++j) X[j] = __builtin_nontemporal_load((const f32x4*)xs_ + F.lane + 64 * j); \
        if (KIND != 0) { const bf16* y_ = (const bf16*)(ws + (KIND == 1 ? WS_YOUT : WS_FOUT)) + (size_t)(r) * D; _Pragma("unroll") for (int j = 0; j < 8; ++j) Y[j] = __builtin_nontemporal_load((const v2u*)y_ + F.lane + 64 * j); } } } while (0)
#define ROW_PROC(r, X, Y) do { ROW_INFO(r, b_, i_, c_, sk_); if (!sk_) { ROW_XPTRS(b_, i_, c_, xs_, xd_); (void)xs_; const int bi_ = c_ ? 8 : b_; LAS f32x4* ST = SETS + (bi_ == biA ? 0 : 1536); \
        if (KIND != 0) { \
            _Pragma("unroll") for (int j = 0; j < 8; ++j) { const f32x4 yy = (f32x4){pg8::bf_lo(Y[j].x), pg8::bf_hi(Y[j].x), pg8::bf_lo(Y[j].y), pg8::bf_hi(Y[j].y)}; X[j] = X[j] * ALPHA + ST[F.lane + 64 * j] * yy; } \
            ln_inplace(X, POST_EPS); \
            _Pragma("unroll") for (int j = 0; j < 8; ++j) X[j] = X[j] * LG[F.lane + 64 * j] + LB[F.lane + 64 * j]; \
            if (poison) { _Pragma("unroll") for (int j = 0; j < 8; ++j) X[j] = X[j] * __builtin_nanf(""); } \
            _Pragma("unroll") for (int j = 0; j < 8; ++j) __builtin_nontemporal_store(X[j], (f32x4*)xd_ + F.lane + 64 * j); } \
        if (want_h) { ln_inplace(X, ADA_EPS); \
            bf16* h_ = (KIND == 1) ? (bf16*)(ws + WS_H2) + (size_t)(r) * D : (bf16*)(ws + WS_P) + (size_t)(r) * LDP + C_YA; \
            _Pragma("unroll") for (int j = 0; j < 8; ++j) { const f32x4 o_ = X[j] * (ST[1024 + F.lane + 64 * j] + 1.0f) + ST[512 + F.lane + 64 * j]; \
                if (KIND == 1) { v2u w_; w_.x = pk2(o_.x, o_.y); w_.y = pk2(o_.z, o_.w); ((v2u*)h_)[F.lane + 64 * j] = w_; } \
                else ((unsigned*)h_)[F.lane + 64 * j] = pk4_fp8(o_.x, o_.y, o_.z, o_.w); } } } } while (0)
        ROW_LOAD(r0, xa, ya);
#pragma unroll 1
        for (int k = 0; k < 8; k += 2) {
            ROW_LOAD(r0 + k + 1, xb, yb);
            ROW_PROC(r0 + k, xa, ya);
            ROW_LOAD(r0 + k + 2, xa, ya);
            ROW_PROC(r0 + k + 1, xb, yb);
        }
        ROW_PROC(r0 + 8, xa, ya);
#undef ROW_INFO
#undef ROW_XPTRS
#undef ROW_LOAD
#undef ROW_PROC
    }
    __syncthreads();
}

__device__ __forceinline__ void unpack8(const v4u x, float (&f)[8]) { f[0] = pg8::bf_lo(x.x); f[1] = pg8::bf_hi(x.x); f[2] = pg8::bf_lo(x.y); f[3] = pg8::bf_hi(x.y); f[4] = pg8::bf_lo(x.z); f[5] = pg8::bf_hi(x.z); f[6] = pg8::bf_lo(x.w); f[7] = pg8::bf_hi(x.w); }
__device__ __forceinline__ v4u pack8(const float (&f)[8]) { v4u o; o.x = pk2(f[0], f[1]); o.y = pk2(f[2], f[3]); o.z = pk2(f[4], f[5]); o.w = pk2(f[6], f[7]); return o; }
__device__ __forceinline__ void prep_phase(const Frame& F0, int l) {
    const Frame F = fresh(F0);
    const int gw = F.vcu * NWAVES + F.wave, NGW = F.G * NWAVES, lane = F.lane;
    unsigned char* ws = ws_ptr(F);
    bf16* P = (bf16*)(ws + WS_P); bf16* CB = (bf16*)(ws + WS_C); bf16* KRR = (bf16*)(ws + WS_KRR); unsigned char* KG8 = ws + WS_KG8;
    const float* kvn = in_ptr(F, I_KVNORM) + (size_t)l * KVR; const float* qn = in_ptr(F, I_QNORM) + (size_t)l * 128; const float* kn = in_ptr(F, I_KNORM) + (size_t)l * 128;
    const bool last = (l == DEPTH - 1);
    LAS float* TMc = (LAS float*)F.lds; LAS float* TMs = TMc + 65 * 16; LAS float* TGc = TMs + 65 * 16; LAS float* TGs = TGc + 65 * 32;
    __syncthreads();
    for (int idx = F.tid; idx < 65 * 16; idx += 512) { const int pos = idx >> 4, i = idx & 15; float sn = 0.f, cs = 1.f; if (pos < 64) sincosf((float)pos * exp2f(-(float)i * (13.287712379549449f / 16.0f)), &sn, &cs); TMc[idx] = cs; TMs[idx] = sn; }
    for (int idx = F.tid; idx < 65 * 32; idx += 512) { const int pos = idx >> 5, i = idx & 31; float sn = 0.f, cs = 1.f; if (pos < 64) sincosf((float)pos * exp2f(-(float)i * (13.287712379549449f / 32.0f)), &sn, &cs); TGc[idx] = cs; TGs[idx] = sn; }
    __syncthreads();
    const int l8 = lane & 7, l16 = lane & 15;
    float g8[8], qg[8], kg[8];
#pragma unroll
    for (int e = 0; e < 8; ++e) { g8[e] = kvn[lane * 8 + e]; qg[e] = qn[l16 * 8 + e]; kg[e] = kn[l16 * 8 + e]; }
    const bool m_col = (l8 >> 2) & 1, m_second = (l8 >> 1) & 1; const int m_i0 = 8 * (l8 & 1);
    const bool g_col = (l16 >> 3) & 1, g_second = (l16 >> 2) & 1; const int g_i0 = 8 * (l16 & 3);
    for (int r = gw; r < M; r += NGW) {
        const int b = r / TPB, i = r - b * TPB; const bool isctx = i >= SEQ;
        bf16* prow = P + (size_t)r * LDP;
        const int posr = isctx ? 64 : (i >> 6), posc = isctx ? 64 : (i & 63);
        { float f[8]; unpack8(*(const v4u*)(prow + C_CKV + lane * 8), f);
          float ss = 0.f;
#pragma unroll
          for (int e = 0; e < 8; ++e) ss += f[e] * f[e];
          const float rr = 1.f / sqrtf(wave_sum(ss) * (1.f / KVR) + RMS_EPS);
#pragma unroll
          for (int e = 0; e < 8; ++e) f[e] = f[e] * rr * g8[e];
          v2u w; w.x = pk4_fp8(f[0], f[1], f[2], f[3]); w.y = pk4_fp8(f[4], f[5], f[6], f[7]); *(v2u*)((unsigned char*)CB + (size_t)r * KVR + lane * 8) = w; }
        float mc[8], ms[8];
        { const int tb = (m_col ? posc : posr) * 16 + m_i0;
          const f32x4 c0 = *(const LAS f32x4*)(TMc + tb), c1 = *(const LAS f32x4*)(TMc + tb + 4), s0 = *(const LAS f32x4*)(TMs + tb), s1 = *(const LAS f32x4*)(TMs + tb + 4);
          mc[0] = c0.x; mc[1] = c0.y; mc[2] = c0.z; mc[3] = c0.w; mc[4] = c1.x; mc[5] = c1.y; mc[6] = c1.z; mc[7] = c1.w;
          ms[0] = s0.x; ms[1] = s0.y; ms[2] = s0.z; ms[3] = s0.w; ms[4] = s1.x; ms[5] = s1.y; ms[6] = s1.z; ms[7] = s1.w; }
#pragma unroll
        for (int p = 0; p < 3; ++p) {
            const bool act = (p == 0) ? (lane < 8) : !isctx;
            const bf16* src = (p == 0) ? prow + C_KR + l8 * 8 : prow + C_MQ + ((p - 1) * 8 + (lane >> 3)) * 192 + 128 + l8 * 8;
            bf16* dst = (p == 0) ? KRR + (size_t)r * 64 + l8 * 8 : (bf16*)src;
            float f[8], o[8]; v4u x = (v4u){0u, 0u, 0u, 0u}; if (act) x = *(const v4u*)src; unpack8(x, f);
#pragma unroll
            for (int e = 0; e < 8; ++e) { const float xp = __shfl_xor(f[e], 2); o[e] = m_second ? (xp * ms[e] + f[e] * mc[e]) : (f[e] * mc[e] - xp * ms[e]); }
            if (act) { if (p == 0) { v2u w; w.x = pk4_fp8(o[0], o[1], o[2], o[3]); w.y = pk4_fp8(o[4], o[5], o[6], o[7]); *(v2u*)((unsigned char*)KRR + (size_t)r * 64 + l8 * 8) = w; } else *(v4u*)dst = pack8(o); }
        }
        float gc[8], gs[8];
        { const int tb = (g_col ? posc : posr) * 32 + g_i0;
          const f32x4 c0 = *(const LAS f32x4*)(TGc + tb), c1 = *(const LAS f32x4*)(TGc + tb + 4), s0 = *(const LAS f32x4*)(TGs + tb), s1 = *(const LAS f32x4*)(TGs + tb + 4);
          gc[0] = c0.x; gc[1] = c0.y; gc[2] = c0.z; gc[3] = c0.w; gc[4] = c1.x; gc[5] = c1.y; gc[6] = c1.z; gc[7] = c1.w;
          gs[0] = s0.x; gs[1] = s0.y; gs[2] = s0.z; gs[3] = s0.w; gs[4] = s1.x; gs[5] = s1.y; gs[6] = s1.z; gs[7] = s1.w; }
        const int p0 = (last && isctx) ? 4 : 0;
        for (int p = p0; p < 5; ++p) {
            const bool isk = (p == 4);
            bf16* q = prow + (isk ? C_GK : C_GQ + p * 512) + (lane >> 4) * 128 + l16 * 8;
            float f[8], o[8]; unpack8(*(const v4u*)q, f);
            float ss = 0.f;
#pragma unroll
            for (int e = 0; e < 8; ++e) ss += f[e] * f[e];
            ss += __shfl_xor(ss, 1); ss += __shfl_xor(ss, 2); ss += __shfl_xor(ss, 4); ss += __shfl_xor(ss, 8);
            const float rr = 1.f / sqrtf(ss * (1.f / 128.f) + RMS_EPS);
#pragma unroll
            for (int e = 0; e < 8; ++e) f[e] = f[e] * rr * (isk ? kg[e] : qg[e]);
#pragma unroll
            for (int e = 0; e < 8; ++e) { const float xp = __shfl_xor(f[e], 4); o[e] = g_second ? (xp * gs[e] + f[e] * gc[e]) : (f[e] * gc[e] - xp * gs[e]); }
            if (isk) { v2u w; w.x = pk4_fp8(o[0], o[1], o[2], o[3]); w.y = pk4_fp8(o[4], o[5], o[6], o[7]); *(v2u*)(KG8 + (size_t)r * 512 + (lane >> 4) * 128 + l16 * 8) = w; }
            else { v2u w; w.x = pk4_fp8(o[0], o[1], o[2], o[3]); w.y = pk4_fp8(o[4], o[5], o[6], o[7]); *(v2u*)((unsigned char*)(q - l16 * 8) + l16 * 8) = w; }
        }
    }
    __syncthreads();
}

__device__ __forceinline__ void conv_fixup(const Frame& F0, int l) {
    const Frame F = fresh(F0);
    unsigned char* ws = ws_ptr(F);
    const bf16* SBG = (const bf16*)(ws + WS_SBG); const bf16* SBV = (const bf16*)(ws + WS_SBV); bf16* A = (bf16*)(ws + WS_A);
    const float* cw = in_ptr(F, I_CONVW) + (size_t)l * 3 * DFF; const float* cb = in_ptr(F, I_CONVB) + (size_t)l * DFF;
    const bool last = (l == DEPTH - 1);
    constexpr int CH = DFF / 8, NBLK = M / 64;
    const int total = NBLK * 2 * CH;
    const v4u Z = (v4u){0u, 0u, 0u, 0u};
    for (int idx = F.vcu * 512 + F.tid; idx < total; idx += F.G * 512) {
        const int ch = idx % CH, bs = idx / CH, s_ = bs & 1, B = bs >> 1, col = ch * 8;
        const int r = B * 64 + (s_ ? 63 : 0), b = r / TPB, i = r - b * TPB;
        if (last && i >= SEQ) continue;
        const bool hasl = (i != 0) && (i != SEQ), hasr = (i != SEQ - 1) && (i != TPB - 1);
        v4u gl, gc, gr, vv;
        if (s_ == 0) { gc = *(const v4u*)(SBG + ((size_t)B * 4 + 0) * DFF + col); gr = *(const v4u*)(SBG + ((size_t)B * 4 + 1) * DFF + col); gl = hasl ? *(const v4u*)(SBG + ((size_t)(B - 1) * 4 + 3) * DFF + col) : Z; vv = *(const v4u*)(SBV + ((size_t)B * 2 + 0) * DFF + col); }
        else { gc = *(const v4u*)(SBG + ((size_t)B * 4 + 3) * DFF + col); gl = *(const v4u*)(SBG + ((size_t)B * 4 + 2) * DFF + col); gr = hasr ? *(const v4u*)(SBG + ((size_t)(B + 1) * 4 + 0) * DFF + col) : Z; vv = *(const v4u*)(SBV + ((size_t)B * 2 + 1) * DFF + col); }
        float fl[8], fc[8], fr[8], fv[8], o[8]; unpack8(gl, fl); unpack8(gc, fc); unpack8(gr, fr); unpack8(vv, fv);
        const f32x4 w0a = *(const f32x4*)(cw + col), w0b = *(const f32x4*)(cw + col + 4), w1a = *(const f32x4*)(cw + DFF + col), w1b = *(const f32x4*)(cw + DFF + col + 4);
        const f32x4 w2a = *(const f32x4*)(cw + 2 * DFF + col), w2b = *(const f32x4*)(cw + 2 * DFF + col + 4), ba = *(const f32x4*)(cb + col), bb = *(const f32x4*)(cb + col + 4);
        const float w0[8] = {w0a.x, w0a.y, w0a.z, w0a.w, w0b.x, w0b.y, w0b.z, w0b.w}, w1[8] = {w1a.x, w1a.y, w1a.z, w1a.w, w1b.x, w1b.y, w1b.z, w1b.w};
        const float w2[8] = {w2a.x, w2a.y, w2a.z, w2a.w, w2b.x, w2b.y, w2b.z, w2b.w}, bs8[8] = {ba.x, ba.y, ba.z, ba.w, bb.x, bb.y, bb.z, bb.w};
#pragma unroll
        for (int e = 0; e < 8; ++e) { const float g = fl[e] * w0[e] + fc[e] * w1[e] + fr[e] * w2[e] + bs8[e]; o[e] = g * __builtin_amdgcn_rcpf(1.0f + __expf(-g)) * fv[e]; }
        *(v4u*)(A + (size_t)r * DFF + col) = pack8(o);
    }
}
__device__ __forceinline__ void attn_phase(const Frame& F0, int l) {
    const Frame F = fresh(F0);
    unsigned char* ws0 = ws_ptr(F); const float* rpb_in = in_ptr(F, I_RPB);
    bf16* P = (bf16*)(ws0 + WS_P); const unsigned char* KM8 = ws0 + WS_KM8; const unsigned char* VM8 = ws0 + WS_VM8; const unsigned char* VN8 = ws0 + WS_VN8; const unsigned char* VG8 = ws0 + WS_VG8; const unsigned char* KRR8 = ws0 + WS_KRR; const unsigned char* KG8 = ws0 + WS_KG8; const unsigned char* KN8 = ws0 + WS_KN8;
    const bool with_ctx = (l < DEPTH - 1);
    LAS char* lds = (LAS char*)F.lds;
    const int swp_ = opq_s((int)(F.vcu & 1));
#pragma unroll 1
    for (int ps_ = 0; ps_ < 2; ++ps_) {
    if (ps_ == swp_)
    { const int nu = 1024 + (with_ctx ? 128 : 0);
      auto mk = [&](int u) -> att::AttnUnit {
        att::AttnUnit U; int b, h, row0;
        if (u < 1024) { b = u >> 7; h = (u >> 3) & 15; row0 = b * TPB + (u & 7) * 256; U.NT = 36; U.n0 = 36; U.base0 = b * TPB; U.base1 = 0; }
        else { const int v = u - 1024; b = v >> 4; h = v & 15; row0 = b * TPB + SEQ; U.NT = 4; U.n0 = 4; U.base0 = b * TPB + SEQ; U.base1 = 0; }
        U.Q = P + (size_t)row0 * LDP + C_MQ + h * 192; U.ldq = LDP;
        U.Kn = nullptr; U.ldkv = 2048; U.Kr = nullptr; U.ldkr = 0; U.V = nullptr; U.K8 = KM8 + h * 128; U.ldk8 = 2048; U.Kr8 = KRR8; U.V8 = VM8 + h * 128; U.ldv8 = 2048;
        U.O = P + (size_t)row0 * LDP + C_YA + h * 128; U.ldo = LDP; U.rpb = nullptr; U.qrow0 = 0; U.krow0 = 0;
        return U; };
      bool pre = false;
      for (int u = F.vcu; u < nu; u += F.G) { const bool hn = (u + F.G) < nu; const att::AttnUnit U = mk(u), N = mk(hn ? u + F.G : u);
        att::attn_body<192, 0, 1>(U, lds, N, hn, pre); pre = hn; }
      }
    if (ps_ != swp_)
    { const int nu = 1024 + (with_ctx ? 256 : 0);
      auto mk = [&](int u) -> att::AttnUnit {
        att::AttnUnit U; int b, h, row0; int cq, cv; bool gqa = true;
        if (u < 1024) { b = u >> 7; h = (u >> 3) & 15; row0 = b * TPB + (u & 7) * 256; U.NT = 36; U.n0 = 36; U.base0 = b * TPB; }
        else { const int v = (u - 1024) & 127; b = v >> 4; h = v & 15; row0 = b * TPB + SEQ; U.NT = 4; U.n0 = 4; U.base0 = b * TPB + SEQ; gqa = (u < 1152); }
        if (gqa) { cq = C_GQ + h * 128; cv = C_GV + (h >> 2) * 128; U.K8 = KG8 + (h >> 2) * 128; U.ldk8 = 512; U.V8 = VG8 + (h >> 2) * 128; U.ldv8 = 512; } else { cq = C_NQ + h * 128; cv = C_NV + h * 128; U.K8 = KN8 + h * 128; U.ldk8 = 2048; U.V8 = VN8 + h * 128; U.ldv8 = 2048; }
        U.base1 = 0;
        U.Q = P + (size_t)row0 * LDP + cq; U.ldq = LDP; U.Kn = nullptr; U.ldkv = LDP; U.Kr = nullptr; U.ldkr = 0; U.V = P + cv;
        U.O = P + (size_t)row0 * LDP + cq; U.ldo = LDP; U.rpb = nullptr; U.qrow0 = 0; U.krow0 = 0; U.Kr8 = nullptr;
        return U; };
      bool pre = false;
      for (int u = F.vcu; u < nu; u += F.G) { const bool hn = (u + F.G) < nu; const att::AttnUnit U = mk(u), N = mk(hn ? u + F.G : u);
        att::attn_body<128, 0, 1, 1>(U, lds, N, hn, pre); pre = hn; }
      }
    }
    { auto mk = [&](int u) -> att::AttnUnit {
        att::AttnUnit U; const int b = u >> 7, h = (u >> 3) & 15, qb = u & 7, row0 = b * TPB + qb * 256;
        int lo = 4 * qb - 4; lo = lo < 0 ? 0 : (lo > 24 ? 24 : lo); if (qb == 6) lo = 20;
        const int nlat = (qb == 0 || qb == 7) ? 8 : 12;
        U.NT = 4 + nlat; U.n0 = 4; U.base0 = b * TPB + SEQ; U.base1 = b * TPB + lo * 64; U.qrow0 = 4 * qb; U.krow0 = lo;
        U.Q = P + (size_t)row0 * LDP + C_NQ + h * 128; U.ldq = LDP; U.Kn = nullptr; U.ldkv = LDP; U.Kr = nullptr; U.ldkr = 0; U.V = P + C_NV + h * 128; U.K8 = KN8 + h * 128; U.ldk8 = 2048; U.Kr8 = nullptr; U.V8 = VN8 + h * 128; U.ldv8 = 2048;
        U.O = P + (size_t)row0 * LDP + C_NQ + h * 128; U.ldo = LDP; U.rpb = rpb_in + (size_t)(l * 16 + h) * 15 * 31;
        return U; };
      bool pre = false;
      for (int u = F.vcu; u < 1024; u += F.G) { const bool hn = (u + F.G) < 1024; const att::AttnUnit U = mk(u), N = mk(hn ? u + F.G : u);
        att::attn_body<128, 1, 1, 1>(U, lds, N, hn, pre); pre = hn; }
      }
}

template <int L>
__device__ __forceinline__ void layer_body(const Frame& F0) {
    constexpr int l = L;
    volatile LAS unsigned* MISC = (volatile LAS unsigned*)(F0.lds + MISC_OFF);
#define GRID_BAR() do { const Frame Fb_ = fresh(F0); volatile LAS unsigned* M_ = (volatile LAS unsigned*)(Fb_.lds + MISC_OFF); XcdBarrier b_; b_.bar = (unsigned*)(ws_ptr(Fb_) + WS_CTL) + CW_BAR; b_.x = (unsigned)__builtin_amdgcn_readfirstlane(M_[10]); b_.st = M_ + 8; xcd_barrier(b_); } while (0)
    {
        constexpr bool last = (l == DEPTH - 1);
        { const Frame F = fresh(F0); unsigned char* ws = ws_ptr(F); const int bx = opq_s(blockIdx.x), Gs = F.G; pg8::Gemm g{(const bf16*)(ws + WS_P) + C_YA, (const bf16*)(ws + WS_WIN), LDP, D / 2, 128}; pg8::StaticOrder S; S.init(M / 256, NP / 256, Gs, bx, 0, 1);
          pg8::EpiWin E{(bf16*)(ws + WS_P), LDP, 1.0f / W8_SCALE, ws, (unsigned char*)(ws + WS_KN8), (unsigned char*)(ws + WS_VN8), (unsigned char*)(ws + WS_VG8), C_NK, C_NV, C_GQ, C_GV, C_GATE, C_NQ};
          pg8::gemm_phase<pg8::EpiWin, true, true, true>(F.lds, g, S, E); }
        GRID_BAR();
        prep_phase(F0, l);
        GRID_BAR();
        { const Frame F = fresh(F0); unsigned char* ws = ws_ptr(F); const int bx = opq_s(blockIdx.x), Gs = F.G; pg8::Gemm g{(const bf16*)(ws + WS_C), (const bf16*)(ws + WS_WUKV), KVR / 2, KVR / 2, 128}; pg8::StaticOrder S; S.init(M / 256, KVW / 256, Gs, bx, 0, 1);
          pg8::EpiKV E{(unsigned char*)(ws + WS_KM8), (unsigned char*)(ws + WS_VM8), 1.0f / WKV_SCALE};
          pg8::gemm_phase<pg8::EpiKV, true, true, true>(F.lds, g, S, E); }
        GRID_BAR();
        attn_phase(F0, l);
        GRID_BAR();
        { const Frame F = fresh(F0); unsigned char* ws = ws_ptr(F); const int bx = opq_s(blockIdx.x), Gs = F.G; pg8::Gemm g{(const bf16*)(ws + WS_P), (const bf16*)(ws + WS_WBR), LDP, D / 2, 256}; pg8::StaticOrder S; S.init(last ? 64 : 72, D / 256, Gs, bx, last ? 1 : 0, 3);
          pg8::EpiMerge E{(bf16*)(ws + WS_ACC), D, (const bf16*)(ws + WS_P) + C_GATE, LDP, C_YA, C_NQ, C_GQ, 1.0f / (WB_SCALE * att::YS), (unsigned char*)(ws + WS_ACC8), ACC_SCALE};
          pg8::gemm_phase<pg8::EpiMerge, true, true, true>(F.lds, g, S, E); }
        GRID_BAR();
        { const Frame F = fresh(F0); unsigned char* ws = ws_ptr(F); const int bx = opq_s(blockIdx.x), Gs = F.G; pg8::Gemm g{(const bf16*)(ws + WS_ACC8), (const bf16*)(ws + WS_WOUT), D / 2, D / 2, 128}; pg8::StaticOrder S; S.init(last ? 64 : 72, D / 256, Gs, bx, last ? 1 : 0, 1);
          pg8::EpiBf16 E{(bf16*)(ws + WS_YOUT), D, 1.0f / (WB_SCALE * ACC_SCALE)};
          pg8::gemm_phase<pg8::EpiBf16, true, true, true>(F.lds, g, S, E); }
        GRID_BAR();
        row_phase<1>(F0, l, false);
        GRID_BAR();
        { const Frame F = fresh(F0); unsigned char* ws = ws_ptr(F); const int bx = opq_s(blockIdx.x), Gs = F.G; pg8::Gemm g{(const bf16*)(ws + WS_H2), (const bf16*)(ws + WS_WUP), D, D, 128}; pg8::StaticOrder S; S.init(last ? 64 : 72, DFF2 / 256, Gs, bx, last ? 1 : 0, 1);
          pg8::EpiConv E{(bf16*)(ws + WS_A), DFF, in_ptr(F, I_CONVW) + (size_t)l * 3 * DFF, in_ptr(F, I_CONVB) + (size_t)l * DFF, (bf16*)(ws + WS_SBG), (bf16*)(ws + WS_SBV)};
          pg8::gemm_phase<pg8::EpiConv, true, true>(F.lds, g, S, E); }
        GRID_BAR();
        conv_fixup(F0, l);
        GRID_BAR();
        { const Frame F = fresh(F0); unsigned char* ws = ws_ptr(F); const int bx = opq_s(blockIdx.x), Gs = F.G; pg8::Gemm g{(const bf16*)(ws + WS_A), (const bf16*)(ws + WS_WDN), DFF, DFF, 128}; pg8::StaticOrder S; S.init(last ? 64 : 72, D / 256, Gs, bx, last ? 1 : 0, 1);
          pg8::EpiBf16 E{(bf16*)(ws + WS_FOUT), D, 1.0f};
          pg8::gemm_phase<pg8::EpiBf16, true, true>(F.lds, g, S, E); }
        GRID_BAR();
        { const Frame F = fresh(F0); const bool poison = last && (xb_ld((unsigned*)(ws_ptr(F) + WS_CTL) + CW_BAR + XB_TMO) != 0u);
          row_phase<2>(F0, l, poison); }
        if (!last) { convert_weights(F0, l + 1); GRID_BAR(); }
    }
}

__global__ void __launch_bounds__(NWAVES * 64, 2) fwd_kernel(Args a) {
    extern __shared__ __attribute__((aligned(16))) unsigned char lds_raw[];
    Frame F;
    F.lds = (LAS unsigned char*)lds_raw;
    F.tid = threadIdx.x; F.lane = F.tid & 63; F.wave = __builtin_amdgcn_readfirstlane(F.tid >> 6);
    F.G = gridDim.x; { const int bx = blockIdx.x; F.vcu = (F.G % 8 == 0) ? (bx % 8) * (F.G / 8) + bx / 8 : bx; }
    volatile LAS unsigned* MISC = (volatile LAS unsigned*)(F.lds + MISC_OFF);
    for (int u = F.tid; u < (LDS_BYTES - LDSCTL_OFF) / 4; u += NWAVES * 64) ((LAS unsigned*)(F.lds + LDSCTL_OFF))[u] = 0u;
    __syncthreads();
    if (F.tid == 0) { LAS unsigned long long* pt = (LAS unsigned long long*)(F.lds + PTAB_OFF);
#pragma unroll
        for (int i = 0; i < 22; ++i) pt[i] = (unsigned long long)a.in[i];
        pt[22] = (unsigned long long)a.out; pt[23] = (unsigned long long)a.ws; }
    __syncthreads();
    { XcdBarrier b0 = xcd_barrier_post((unsigned*)(ws_ptr(F) + WS_CTL) + CW_BAR, MISC + 8); if (F.tid == 0) MISC[10] = b0.x; }
    __syncthreads();

    { const Frame& F0 = F;
    adaln_partial(F);
    convert_weights(F, 0);
    GRID_BAR();
    adaln_final(F);
    GRID_BAR();
    row_phase<0>(F, 0, false);
    GRID_BAR(); }

    layer_body<0>(F);
    layer_body<1>(F);
}

extern "C" void kernel_launch(void* const* d_in, const int* in_sizes, int n_in, void* d_out, int out_size, void* d_ws, size_t ws_size, hipStream_t stream) {
    static int grid = 0;
    if (grid == 0) {
        if (n_in != 22 || out_size != NB * SEQ * D || ws_size < WS_END) { fprintf(stderr, "kernel_launch: shape/workspace mismatch (n_in %d out %d ws %zu need %zu)\n", n_in, out_size, ws_size, (size_t)WS_END); grid = -1; return; }
        int dev = 0, cus = 0, per_cu = 0;
        if (hipGetDevice(&dev) != hipSuccess || hipDeviceGetAttribute(&cus, hipDeviceAttributeMultiprocessorCount, dev) != hipSuccess) { grid = -1; return; }
        if (hipFuncSetAttribute((const void*)fwd_kernel, hipFuncAttributeMaxDynamicSharedMemorySize, LDS_BYTES) != hipSuccess) { grid = -1; return; }
        if (hipOccupancyMaxActiveBlocksPerMultiprocessor(&per_cu, (const void*)fwd_kernel, NWAVES * 64, LDS_BYTES) != hipSuccess || per_cu < 1) fprintf(stderr, "kernel_launch: occupancy query reports %d\n", per_cu);
        (void)hipGetLastError();
        grid = cus;
    }
    if (grid < 0) return;
    if (hipMemsetAsync((char*)d_ws + WS_CTL, 0, CTL_ZERO_BYTES, stream) != hipSuccess) return;
    Args a{};
    for (int i = 0; i < 22; ++i) a.in[i] = (const float*)d_in[i];
    a.out = (float*)d_out; a.ws = (unsigned char*)d_ws;
    hipLaunchKernelGGL(fwd_kernel, dim3(grid), dim3(NWAVES * 64), LDS_BYTES, stream, a);
    const hipError_t le = hipPeekAtLastError();
    if (le != hipSuccess) fprintf(stderr, "kernel_launch: launch failed: %s\n", hipGetErrorName(le));
}
```

```cpp
#include <hip/hip_runtime.h>
#include <cstdio>
#include <cstdint>
namespace pg8 {
#define PG8_LAS __attribute__((address_space(3)))
typedef unsigned short bf16_t;
typedef short bf16x8 __attribute__((ext_vector_type(8)));
typedef float f32x4 __attribute__((ext_vector_type(4)));
typedef unsigned u32x4 __attribute__((ext_vector_type(4)));
constexpr int BM = 256, BK = 64, HALF = 128, HTB = HALF * BK * 2, STAGE_BYTES = 8 * HTB, NXCD = 8, WGM = 8;

__host__ __device__ __forceinline__ int lds_byte(int r, int c) { const int st = (r >> 4) * 2 + (c >> 5), rr = r & 15, cc = c & 31, ob = rr * 64 + cc * 2; return st * 1024 + (ob ^ (((ob >> 9) & 1) << 5)); }
__host__ __device__ __forceinline__ void stage_rc(int b, int& R, int& C) { const int st = b / 1024, sb = b % 1024, swz = sb ^ (((sb >> 9) & 1) << 5); R = (st >> 1) * 16 + swz / 64; C = (st & 1) * 32 + (swz % 64) / 2; }
__host__ __device__ __forceinline__ int perm32(int rho) { const int n = rho >> 4, i = rho & 15; return 8 * (i >> 2) + 4 * n + (i & 3); }

struct Unit { int pm, pn, z; };
struct Gemm { const bf16_t* A; const bf16_t* Bt; int lda, K, kstepA; };

struct StaticOrder {
    int nM, nN, nwg, G, c, skip9, nz, nlat;
    __device__ void init(int nM_, int nN_, int G_, int c_, int skip9_, int nz_, int nctx25_ = 0) { nM = nM_; nN = nN_; nlat = nM * nN; nwg = nlat + nctx25_ * 25; G = G_; c = c_; skip9 = skip9_; nz = nz_; }
    __device__ bool next(int i, Unit& u) const {
        const int it = i / nz; u.z = i - it * nz;
        const long L = (long)it * G + c; if (L >= nwg) return false;
        int wgid = (int)L; { const int q = nwg / NXCD, r = nwg % NXCD, xcd = wgid % NXCD, off = wgid / NXCD; wgid = (xcd < r ? xcd * (q + 1) : r * (q + 1) + (xcd - r) * q) + off; }
        if (wgid >= nlat) { const int j_ = wgid - nlat, i_ = j_ / 25, jj = j_ - i_ * 25; u.pm = 9 * i_ + 8; u.pn = jj < 3 ? 12 + jj : (jj < 20 ? 19 + jj : 26 + jj); return true; }
        const int nig = WGM * nN, gid = wgid / nig, fm = gid * WGM, gsz = (nM - fm) < WGM ? (nM - fm) : WGM;
        int pm = fm + ((wgid % nig) % gsz); u.pn = (wgid % nig) / gsz;
        if (skip9) pm += pm >> 3;
        u.pm = pm; return true;
    }
};

__device__ __forceinline__ unsigned cvt_pk_bf16(float lo, float hi) { unsigned r; asm volatile("v_cvt_pk_bf16_f32 %0, %1, %2" : "=v"(r) : "v"(lo), "v"(hi)); return r; }

struct EpiF32 {
    static constexpr bool PERM = false; static constexpr int NST = 16;
    float* C; int ldc; float scale;
    __device__ __forceinline__ size_t aoff(const Unit& u, int lda) const { return (size_t)u.pm * BM * lda * 2; }
    __device__ __forceinline__ size_t boff(const Unit& u, int K) const { return (size_t)u.pn * BM * K * 2; }
    __device__ __forceinline__ void operator()(const f32x4 (&acc)[2][2][4][2], const Unit& u, int wr, int wc, int fr, int fq) const {
        const int row0 = u.pm * BM + wr * 64 + fr, col0 = u.pn * BM + wc * 32 + 4 * fq;
#pragma unroll
        for (int ai = 0; ai < 2; ++ai)
#pragma unroll
            for (int m = 0; m < 4; ++m) { float* rowp = C + (size_t)(row0 + ai * HALF + m * 16) * ldc + col0;
#pragma unroll
                for (int bj = 0; bj < 2; ++bj)
#pragma unroll
                    for (int n = 0; n < 2; ++n) *(f32x4*)(rowp + bj * HALF + n * 16) = acc[ai][bj][m][n] * scale; }
    }
};
struct EpiBf16 {
    static constexpr bool PERM = true; static constexpr int NST = 16;
    bf16_t* O; int ldc; float scale;
    __device__ __forceinline__ size_t aoff(const Unit& u, int lda) const { return (size_t)u.pm * BM * lda * 2; }
    __device__ __forceinline__ size_t boff(const Unit& u, int K) const { return (size_t)u.pn * BM * K * 2; }
    __device__ __forceinline__ void operator()(const f32x4 (&acc)[2][2][4][2], const Unit& u, int wr, int wc, int fr, int fq) const {
        const int row0 = u.pm * BM + wr * 64 + fr, col0 = u.pn * BM + wc * 32 + 8 * fq;
#pragma unroll
        for (int ai = 0; ai < 2; ++ai)
#pragma unroll
            for (int m = 0; m < 4; ++m) { bf16_t* rowp = O + (size_t)(row0 + ai * HALF + m * 16) * ldc + col0;
#pragma unroll
                for (int bj = 0; bj < 2; ++bj) { const f32x4 v0 = acc[ai][bj][m][0] * scale, v1 = acc[ai][bj][m][1] * scale;
                    u32x4 w; w.x = cvt_pk_bf16(v0[0], v0[1]); w.y = cvt_pk_bf16(v0[2], v0[3]); w.z = cvt_pk_bf16(v1[0], v1[1]); w.w = cvt_pk_bf16(v1[2], v1[3]);
                    *(u32x4*)(rowp + bj * HALF) = w; } }
    }
};
struct EpiKV {
    static constexpr bool PERM = true; static constexpr int NST = 16;
    unsigned char* K8; unsigned char* V8; float scale;
    __device__ __forceinline__ size_t aoff(const Unit& u, int lda) const { return (size_t)u.pm * BM * lda * 2; }
    __device__ __forceinline__ size_t boff(const Unit& u, int K) const { return (size_t)u.pn * BM * K * 2; }
    __device__ __forceinline__ void operator()(const f32x4 (&acc)[2][2][4][2], const Unit& u, int wr, int wc, int fr, int fq) const {
        const int row0 = u.pm * BM + wr * 64 + fr, col0 = u.pn * 128 + wc * 32 + 8 * fq;
        typedef unsigned u32x2 __attribute__((ext_vector_type(2)));
#pragma unroll
        for (int ai = 0; ai < 2; ++ai)
#pragma unroll
            for (int m = 0; m < 4; ++m) { const size_t row = (size_t)(row0 + ai * HALF + m * 16);
                { const f32x4 v0 = acc[ai][0][m][0] * scale, v1 = acc[ai][0][m][1] * scale; int w0 = 0, w1 = 0;
                  w0 = __builtin_amdgcn_cvt_pk_fp8_f32(v0[0], v0[1], w0, false); w0 = __builtin_amdgcn_cvt_pk_fp8_f32(v0[2], v0[3], w0, true);
                  w1 = __builtin_amdgcn_cvt_pk_fp8_f32(v1[0], v1[1], w1, false); w1 = __builtin_amdgcn_cvt_pk_fp8_f32(v1[2], v1[3], w1, true);
                  *(u32x2*)(K8 + row * 2048 + col0) = (u32x2){(unsigned)w0, (unsigned)w1}; }
                { const f32x4 v0 = acc[ai][1][m][0] * scale, v1 = acc[ai][1][m][1] * scale; int w0 = 0, w1 = 0;
                  w0 = __builtin_amdgcn_cvt_pk_fp8_f32(v0[0], v0[1], w0, false); w0 = __builtin_amdgcn_cvt_pk_fp8_f32(v0[2], v0[3], w0, true);
                  w1 = __builtin_amdgcn_cvt_pk_fp8_f32(v1[0], v1[1], w1, false); w1 = __builtin_amdgcn_cvt_pk_fp8_f32(v1[2], v1[3], w1, true);
                  *(u32x2*)(V8 + row * 2048 + col0) = (u32x2){(unsigned)w0, (unsigned)w1}; } }
    }
};
struct EpiWin {
    static constexpr bool PERM = true; static constexpr int NST = 8;
    bf16_t* O; int ldc; float scale; unsigned char* base8; unsigned char* KN8; unsigned char* VN8; unsigned char* VG8; int c_nk, c_nv, c_gq, c_gv, c_gate, c_nq;
    __device__ __forceinline__ size_t aoff(const Unit& u, int lda) const { return (size_t)u.pm * BM * lda * 2; }
    __device__ __forceinline__ size_t boff(const Unit& u, int K) const { return (size_t)u.pn * BM * K * 2; }
    __device__ __forceinline__ void operator()(const f32x4 (&acc)[2][2][4][2], const Unit& u, int wr, int wc, int fr, int fq) const {
        const int row0 = u.pm * BM + wr * 64 + fr, col = u.pn * BM + wc * 64 + 8 * fq;
        const bool in_nk = (col >= c_nk) && (col < c_nv), in_nv = (col >= c_nv) && (col < c_gq), in_gv = (col >= c_gv) && (col < c_gate), in_gt = (col >= c_gate) && (col < c_gate + 6144), in_nq = (col >= c_nq) && (col < c_nk), is8 = in_nk || in_nv || in_gv || in_gt || in_nq;
        const float sc = in_gt ? scale * -1.4426950408889634f : scale;
        if (is8) {
            const size_t a8 = (in_nk ? (size_t)(KN8 - base8) + (size_t)(col - c_nk) : 0) + (in_nv ? (size_t)(VN8 - base8) + (size_t)(col - c_nv) : 0) + (in_gv ? (size_t)(VG8 - base8) + (size_t)(col - c_gv) : 0) + (in_gt ? (size_t)((unsigned char*)O - base8) + (size_t)c_gate * 2 + (size_t)(col - c_gate) : 0)
                + (in_nq ? (size_t)((unsigned char*)O - base8) + (size_t)c_nq * 2 + (size_t)(((col - c_nq) >> 7) * 256 + ((col - c_nq) & 127)) : 0);
            const int ld8 = in_gv ? 512 : ((in_gt || in_nq) ? ldc * 2 : 2048);
            unsigned char* dl = base8 + a8 + ((fq & 1) ? 24 : 0);
#pragma unroll
            for (int ai = 0; ai < 2; ++ai)
#pragma unroll
                for (int m = 0; m < 4; ++m) { const size_t row = (size_t)(row0 + ai * HALF + m * 16);
                    unsigned b0[2], b1[2];
#pragma unroll
                    for (int bj = 0; bj < 2; ++bj) { const f32x4 v0 = acc[ai][bj][m][0] * sc, v1 = acc[ai][bj][m][1] * sc; int w0 = 0, w1 = 0;
                        w0 = __builtin_amdgcn_cvt_pk_fp8_f32(v0[0], v0[1], w0, false); w0 = __builtin_amdgcn_cvt_pk_fp8_f32(v0[2], v0[3], w0, true);
                        w1 = __builtin_amdgcn_cvt_pk_fp8_f32(v1[0], v1[1], w1, false); w1 = __builtin_amdgcn_cvt_pk_fp8_f32(v1[2], v1[3], w1, true);
                        if (bj == 0) { b0[0] = (unsigned)w0; b0[1] = (unsigned)w1; } else { b1[0] = (unsigned)w0; b1[1] = (unsigned)w1; } }
                    { auto r = __builtin_amdgcn_permlane16_swap(b0[0], b1[0], false, false); b0[0] = r[0]; b1[0] = r[1]; }
                    { auto r = __builtin_amdgcn_permlane16_swap(b0[1], b1[1], false, false); b0[1] = r[0]; b1[1] = r[1]; }
                    *(u32x4*)(dl + row * ld8) = (u32x4){b0[0], b0[1], b1[0], b1[1]}; }
        } else {
            const int hi8 = fr >> 3; bf16_t* ob = O + col + 32 * hi8;
#pragma unroll
            for (int ai = 0; ai < 2; ++ai)
#pragma unroll
                for (int m = 0; m < 4; ++m) { const size_t row = (size_t)(row0 + ai * HALF + m * 16);
                    unsigned b0[4], b1[4], n0[4], n1[4];
                    { const f32x4 v0 = acc[ai][0][m][0] * sc, v1 = acc[ai][0][m][1] * sc; b0[0] = cvt_pk_bf16(v0[0], v0[1]); b0[1] = cvt_pk_bf16(v0[2], v0[3]); b0[2] = cvt_pk_bf16(v1[0], v1[1]); b0[3] = cvt_pk_bf16(v1[2], v1[3]); }
                    { const f32x4 v0 = acc[ai][1][m][0] * sc, v1 = acc[ai][1][m][1] * sc; b1[0] = cvt_pk_bf16(v0[0], v0[1]); b1[1] = cvt_pk_bf16(v0[2], v0[3]); b1[2] = cvt_pk_bf16(v1[0], v1[1]); b1[3] = cvt_pk_bf16(v1[2], v1[3]); }
#pragma unroll
                    for (int d = 0; d < 4; ++d) {
                        n0[d] = (unsigned)__builtin_amdgcn_update_dpp((int)b0[d], (int)b1[d], 0x128, 0xf, 0xc, false);
                        n1[d] = (unsigned)__builtin_amdgcn_update_dpp((int)b1[d], (int)b0[d], 0x128, 0xf, 0x3, false); }
                    *(u32x4*)(ob + (row - 8 * hi8) * ldc) = (u32x4){n0[0], n0[1], n0[2], n0[3]};
                    *(u32x4*)(ob + (row + 8 - 8 * hi8) * ldc) = (u32x4){n1[0], n1[1], n1[2], n1[3]}; }
        }
    }
};
__device__ __forceinline__ float dpp_ror1(float x) { return __builtin_bit_cast(float, __builtin_amdgcn_update_dpp(0, __builtin_bit_cast(int, x), 0x121, 0xf, 0xf, false)); }
__device__ __forceinline__ float dpp_ror15(float x) { return __builtin_bit_cast(float, __builtin_amdgcn_update_dpp(0, __builtin_bit_cast(int, x), 0x12f, 0xf, 0xf, false)); }
struct EpiConv {
    static constexpr bool PERM = true; static constexpr int NST = 8;
    bf16_t* A; int dff; const float* cw; const float* cb; bf16_t* SBG; bf16_t* SBV;
    __device__ __forceinline__ size_t aoff(const Unit& u, int lda) const { return (size_t)u.pm * BM * lda * 2; }
    __device__ __forceinline__ size_t boff(const Unit& u, int K) const { return (size_t)u.pn * BM * K * 2; }
    __device__ __forceinline__ void operator()(const f32x4 (&acc)[2][2][4][2], const Unit& u, int wr, int wc, int fr, int fq) const {
        const int col = u.pn * 128 + wc * 32 + 8 * fq;
        float w0[8], w1[8], w2[8], bs[8];
        { const f32x4 a0 = *(const f32x4*)(cw + col), a1 = *(const f32x4*)(cw + col + 4), b0 = *(const f32x4*)(cw + dff + col), b1 = *(const f32x4*)(cw + dff + col + 4);
          const f32x4 c0 = *(const f32x4*)(cw + 2 * dff + col), c1 = *(const f32x4*)(cw + 2 * dff + col + 4), d0 = *(const f32x4*)(cb + col), d1 = *(const f32x4*)(cb + col + 4);
#pragma unroll
          for (int e = 0; e < 4; ++e) { w0[e] = a0[e]; w0[4 + e] = a1[e]; w1[e] = b0[e]; w1[4 + e] = b1[e]; w2[e] = c0[e]; w2[4 + e] = c1[e]; bs[e] = d0[e]; bs[4 + e] = d1[e]; } }
#pragma unroll
        for (int ai = 0; ai < 2; ++ai) {
            const int blk = u.pm * 4 + ai * 2 + wr; const size_t row0 = (size_t)u.pm * BM + ai * HALF + wr * 64 + fr;
#pragma unroll
            for (int m = 0; m < 4; ++m) {
                float o[8];
#pragma unroll
                for (int e = 0; e < 8; ++e) { const float gcur = acc[ai][0][m][e >> 2][e & 3];
                    const float pm1 = (m > 0) ? acc[ai][0][m > 0 ? m - 1 : 0][e >> 2][e & 3] : 0.f, pp1 = (m < 3) ? acc[ai][0][m < 3 ? m + 1 : 3][e >> 2][e & 3] : 0.f;
                    const float ra = dpp_ror1(gcur), rb = dpp_ror1(pm1), sa = dpp_ror15(gcur), sb = dpp_ror15(pp1);
                    const float gprev = (fr == 0) ? rb : ra, gnext = (fr == 15) ? sb : sa;
                    const float x = gprev * w0[e] + gcur * w1[e] + gnext * w2[e] + bs[e];
                    o[e] = x * __builtin_amdgcn_rcpf(1.0f + __expf(-x)) * acc[ai][1][m][e >> 2][e & 3]; }
                const bool boundary = (m == 0 && fr == 0) || (m == 3 && fr == 15);
                if (!boundary) { u32x4 w; w.x = cvt_pk_bf16(o[0], o[1]); w.y = cvt_pk_bf16(o[2], o[3]); w.z = cvt_pk_bf16(o[4], o[5]); w.w = cvt_pk_bf16(o[6], o[7]);
                    *(u32x4*)(A + (row0 + m * 16) * dff + col) = w; }
                if (m == 0 || m == 3) {
                    const bool sg = (m == 0) ? (fr < 2) : (fr >= 14); const int slot = (m == 0) ? fr : 2 + (fr - 14);
                    if (sg) { const f32x4 g0 = acc[ai][0][m][0], g1 = acc[ai][0][m][1]; u32x4 w; w.x = cvt_pk_bf16(g0[0], g0[1]); w.y = cvt_pk_bf16(g0[2], g0[3]); w.z = cvt_pk_bf16(g1[0], g1[1]); w.w = cvt_pk_bf16(g1[2], g1[3]);
                        *(u32x4*)(SBG + ((size_t)blk * 4 + slot) * dff + col) = w; }
                    const bool sv = (m == 0) ? (fr == 0) : (fr == 15);
                    if (sv) { const f32x4 v0 = acc[ai][1][m][0], v1 = acc[ai][1][m][1]; u32x4 w; w.x = cvt_pk_bf16(v0[0], v0[1]); w.y = cvt_pk_bf16(v0[2], v0[3]); w.z = cvt_pk_bf16(v1[0], v1[1]); w.w = cvt_pk_bf16(v1[2], v1[3]);
                        *(u32x4*)(SBV + ((size_t)blk * 2 + (m == 0 ? 0 : 1)) * dff + col) = w; } }
            }
        }
    }
};
__device__ __forceinline__ float bf_lo(unsigned w) { return __uint_as_float(w << 16); }
__device__ __forceinline__ float bf_hi(unsigned w) { return __uint_as_float(w & 0xffff0000u); }
__device__ __forceinline__ float sigmoidf_(float x) { return __builtin_amdgcn_rcpf(1.0f + __expf(-x)); }
struct EpiMerge {
    static constexpr bool PERM = true; static constexpr int NST = 16;
    bf16_t* ACC; int ldc; const bf16_t* G; int ldg; int acol0, acol1, acol2; float scale; unsigned char* ACC8; float oscale;
    __device__ __forceinline__ size_t aoff(const Unit& u, int lda) const { const int ac = (u.z == 0) ? acol0 : acol1 + (u.z - 1) * (acol2 - acol1); return (size_t)u.pm * BM * lda * 2 + (size_t)ac * 2; }
    __device__ __forceinline__ size_t boff(const Unit& u, int K) const { return (size_t)(u.z * 2048 + u.pn * BM) * K * 2; }
    __device__ __forceinline__ void operator()(const f32x4 (&acc)[2][2][4][2], const Unit& u, int wr, int wc, int fr, int fq) const {
        const int row0 = u.pm * BM + wr * 64 + fr, col0 = u.pn * BM + wc * 32 + 8 * fq;
        typedef unsigned u32x2 __attribute__((ext_vector_type(2)));
#pragma unroll
        for (int ai = 0; ai < 2; ++ai) {
            u32x2 gv[4][2]; u32x4 pv[4][2];
#pragma unroll
            for (int m = 0; m < 4; ++m) { const size_t row = (size_t)(row0 + ai * HALF + m * 16); const unsigned char* gp = (const unsigned char*)G + row * ldg * 2 + u.z * 2048 + col0; const bf16_t* rowp = ACC + row * ldc + col0;
#pragma unroll
                for (int bj = 0; bj < 2; ++bj) { gv[m][bj] = *(const u32x2*)(gp + bj * HALF); pv[m][bj] = (u32x4){0u, 0u, 0u, 0u}; if (u.z != 0) pv[m][bj] = *(const u32x4*)(rowp + bj * HALF); } }
#pragma unroll
            for (int m = 0; m < 4; ++m) { const size_t row = (size_t)(row0 + ai * HALF + m * 16); bf16_t* rowp = ACC + row * ldc + col0; unsigned char* r8 = ACC8 + row * 2048 + col0;
#pragma unroll
                for (int bj = 0; bj < 2; ++bj) { const f32x4 v0 = acc[ai][bj][m][0] * scale, v1 = acc[ai][bj][m][1] * scale; const u32x2 g = gv[m][bj]; const u32x4 p = pv[m][bj];
                    const auto g0 = __builtin_amdgcn_cvt_pk_f32_fp8((int)g.x, false), g1 = __builtin_amdgcn_cvt_pk_f32_fp8((int)g.x, true), g2 = __builtin_amdgcn_cvt_pk_f32_fp8((int)g.y, false), g3 = __builtin_amdgcn_cvt_pk_f32_fp8((int)g.y, true);
#define SG_(x) __builtin_amdgcn_rcpf(1.0f + __builtin_amdgcn_exp2f(x))
                    float o[8];
                    o[0] = bf_lo(p.x) + SG_(g0[0]) * v0[0]; o[1] = bf_hi(p.x) + SG_(g0[1]) * v0[1];
                    o[2] = bf_lo(p.y) + SG_(g1[0]) * v0[2]; o[3] = bf_hi(p.y) + SG_(g1[1]) * v0[3];
                    o[4] = bf_lo(p.z) + SG_(g2[0]) * v1[0]; o[5] = bf_hi(p.z) + SG_(g2[1]) * v1[1];
                    o[6] = bf_lo(p.w) + SG_(g3[0]) * v1[2]; o[7] = bf_hi(p.w) + SG_(g3[1]) * v1[3];
#undef SG_
                    if (u.z != 2) { u32x4 w; w.x = cvt_pk_bf16(o[0], o[1]); w.y = cvt_pk_bf16(o[2], o[3]); w.z = cvt_pk_bf16(o[4], o[5]); w.w = cvt_pk_bf16(o[6], o[7]);
                        *(u32x4*)(rowp + bj * HALF) = w; }
                    else { int w0 = 0, w1 = 0; w0 = __builtin_amdgcn_cvt_pk_fp8_f32(o[0] * oscale, o[1] * oscale, w0, false); w0 = __builtin_amdgcn_cvt_pk_fp8_f32(o[2] * oscale, o[3] * oscale, w0, true);
                        w1 = __builtin_amdgcn_cvt_pk_fp8_f32(o[4] * oscale, o[5] * oscale, w1, false); w1 = __builtin_amdgcn_cvt_pk_fp8_f32(o[6] * oscale, o[7] * oscale, w1, true);
                        *(u32x2*)(r8 + bj * HALF) = (u32x2){(unsigned)w0, (unsigned)w1}; } } }
        }
    }
};

typedef int i32x4 __attribute__((ext_vector_type(4)));
typedef int i32x8 __attribute__((ext_vector_type(8)));
template <class Epi, bool ALIGN_EPI, bool SP2, bool FP8 = false>
__device__ __forceinline__ void gemm_phase(PG8_LAS unsigned char* lds, const Gemm g, const StaticOrder& S, const Epi& E) {
    int tid_ = threadIdx.x; asm volatile("" : "+v"(tid_));
    const int tid = tid_, wid = __builtin_amdgcn_readfirstlane(tid >> 6), lane = tid & 63, wr = wid >> 2, wc = wid & 3, fr = lane & 15, fq = lane >> 4;
    const int K = g.K, nt = K / BK, lda = g.lda;
    unsigned voffA[2], voffB[2];
#pragma unroll
    for (int i = 0; i < 2; ++i) { int R, C; stage_rc(tid * 16 + i * 8192, R, C); const int Rb = Epi::PERM ? ((R & ~31) + perm32(R & 31)) : R;
        voffA[i] = (unsigned)(R * lda + C) * 2u; voffB[i] = (unsigned)(Rb * K + C) * 2u; }
    const size_t kstep = (size_t)(BK * 2), kstepA = (size_t)g.kstepA;
    const size_t hstepA = (size_t)HALF * lda * 2, hstepB = (size_t)HALF * K * 2;
    const unsigned ldsw = (unsigned)wid * 1024u;
    const int aoff = lds_byte(wr * 64 + fr, fq * 8), boff = lds_byte(wc * 32 + fr, fq * 8);
#define PG8_SA(b, h) (((b) * 2 + (h)) * HTB)
#define PG8_SB(b, h) ((4 + (b) * 2 + (h)) * HTB)
#define PG8_STAGE(bufoff, gbase, voff) do { _Pragma("unroll") for (int _i = 0; _i < 2; ++_i) \
        __builtin_amdgcn_global_load_lds((const unsigned*)((const char*)(gbase) + (voff)[_i]), (PG8_LAS unsigned*)(lds + (bufoff) + ldsw + _i * 8192), 16, 0, 0); } while (0)
#define PG8_LDA(dst, b, h) do { _Pragma("unroll") for (int m = 0; m < 4; ++m) { const i32x4 lo_ = *(const PG8_LAS i32x4*)(lds + PG8_SA(b, h) + aoff + m * 2048), hi_ = *(const PG8_LAS i32x4*)(lds + PG8_SA(b, h) + aoff + m * 2048 + 1024); dst[m] = __builtin_shufflevector(lo_, hi_, 0, 1, 2, 3, 4, 5, 6, 7); } } while (0)
#define PG8_LDB(dst, b, h) do { _Pragma("unroll") for (int n = 0; n < 2; ++n) { const i32x4 lo_ = *(const PG8_LAS i32x4*)(lds + PG8_SB(b, h) + boff + n * 2048), hi_ = *(const PG8_LAS i32x4*)(lds + PG8_SB(b, h) + boff + n * 2048 + 1024); dst[n] = __builtin_shufflevector(lo_, hi_, 0, 1, 2, 3, 4, 5, 6, 7); } } while (0)
#define PG8_LO(x) __builtin_bit_cast(bf16x8, __builtin_shufflevector(x, x, 0, 1, 2, 3))
#define PG8_HI(x) __builtin_bit_cast(bf16x8, __builtin_shufflevector(x, x, 4, 5, 6, 7))
#define PG8_MMA(ai, bj, At, Bt) do { __builtin_amdgcn_s_setprio(1); if constexpr (FP8) { _Pragma("unroll") for (int m = 0; m < 4; ++m) _Pragma("unroll") for (int n = 0; n < 2; ++n) \
        asm volatile("v_mfma_scale_f32_16x16x128_f8f6f4 %0, %1, %2, %0, %3, %3 op_sel_hi:[0,0,0]" : "+v"(acc[ai][bj][m][n]) : "v"(Bt[n]), "v"(At[m]), "v"(one_scale)); } else { \
        _Pragma("unroll") for (int m = 0; m < 4; ++m) _Pragma("unroll") for (int n = 0; n < 2; ++n) { \
        acc[ai][bj][m][n] = __builtin_amdgcn_mfma_f32_16x16x32_bf16(PG8_LO(Bt[n]), PG8_LO(At[m]), acc[ai][bj][m][n], 0, 0, 0); \
        acc[ai][bj][m][n] = __builtin_amdgcn_mfma_f32_16x16x32_bf16(PG8_HI(Bt[n]), PG8_HI(At[m]), acc[ai][bj][m][n], 0, 0, 0); } } __builtin_amdgcn_s_setprio(0); } while (0)
#define PG8_WAIT_V(n) asm volatile("s_waitcnt vmcnt(" #n ")" ::: "memory")
#define PG8_WAIT_VN(N) asm volatile("s_waitcnt vmcnt(%0)" :: "n"(N) : "memory")
#define PG8_WAIT_L(n) asm volatile("s_waitcnt lgkmcnt(" #n ")" ::: "memory")
#define PG8_BAR __builtin_amdgcn_s_barrier()
#define PG8_SCHED __builtin_amdgcn_sched_barrier(0)
    Unit cur, nxt; int ui = 0;
    if (!S.next(0, cur)) return;
    f32x4 acc[2][2][4][2];
#pragma unroll
    for (int a = 0; a < 2; ++a)
#pragma unroll
        for (int b = 0; b < 2; ++b)
#pragma unroll
            for (int m = 0; m < 4; ++m)
#pragma unroll
                for (int n = 0; n < 2; ++n) acc[a][b][m][n] = (f32x4){0.f, 0.f, 0.f, 0.f};
    i32x8 At[4], B0[2], B1[2];
    const int one_scale = 0x7F7F7F7F;
    const char* cA = (const char*)g.A + E.aoff(cur, lda); const char* cB = (const char*)g.Bt + E.boff(cur, K);
    if constexpr (SP2) {
        PG8_STAGE(PG8_SB(0, 0), cB, voffB); PG8_STAGE(PG8_SB(0, 1), cB + hstepB, voffB); PG8_STAGE(PG8_SA(0, 0), cA, voffA); PG8_STAGE(PG8_SA(0, 1), cA + hstepA, voffA);
        if (wr == 1) PG8_BAR;
        PG8_WAIT_V(2); PG8_BAR;
        PG8_STAGE(PG8_SB(1, 0), cB + kstep, voffB); PG8_STAGE(PG8_SA(1, 0), cA + kstepA, voffA); PG8_STAGE(PG8_SB(1, 1), cB + hstepB + kstep, voffB);
        PG8_WAIT_V(6); PG8_BAR;
    } else {
        PG8_STAGE(PG8_SB(0, 0), cB, voffB); PG8_STAGE(PG8_SA(0, 0), cA, voffA); PG8_STAGE(PG8_SB(0, 1), cB + hstepB, voffB); PG8_STAGE(PG8_SA(0, 1), cA + hstepA, voffA);
        if (wr == 1) PG8_BAR;
        PG8_WAIT_V(4); PG8_BAR;
        PG8_STAGE(PG8_SB(1, 0), cB + kstep, voffB); PG8_STAGE(PG8_SA(1, 0), cA + kstepA, voffA); PG8_STAGE(PG8_SB(1, 1), cB + hstepB + kstep, voffB);
        PG8_WAIT_V(6); PG8_BAR;
    }
    for (;;) {
        const bool has_next = S.next(ui + 1, nxt);
        const char* nA = has_next ? (const char*)g.A + E.aoff(nxt, lda) : cA; const char* nB = has_next ? (const char*)g.Bt + E.boff(nxt, K) : cB;
        for (int t = 0; t < nt; t += 2) {
            const bool last = (t == nt - 2);
            const char* a1 = cA + (size_t)(t + 1) * kstepA;
            const char* a2 = last ? nA : cA + (size_t)(t + 2) * kstepA; const char* b2 = last ? nB : cB + (size_t)(t + 2) * kstep;
            const char* a3 = a2 + kstepA; const char* b3 = b2 + kstep;
            if constexpr (SP2) {
            int relax_ = __builtin_amdgcn_readfirstlane(((t == 0) && (ui > 0)) ? 1 : 0); asm volatile("" : "+s"(relax_));
#define PG8_WAIT_R() do { if (relax_) PG8_WAIT_VN(8 + Epi::NST); else PG8_WAIT_V(8); } while (0)
            PG8_LDB(B0, 0, 0); PG8_LDB(B1, 0, 1); PG8_SCHED; PG8_LDA(At, 0, 0); PG8_STAGE(PG8_SA(1, 1), a1 + hstepA, voffA);
            PG8_WAIT_R(); PG8_WAIT_L(0); PG8_BAR; PG8_MMA(0, 0, At, B0); PG8_MMA(0, 1, At, B1); PG8_BAR; PG8_SCHED;
            PG8_LDA(At, 0, 1); PG8_STAGE(PG8_SB(0, 0), b2, voffB); PG8_STAGE(PG8_SB(0, 1), b2 + hstepB, voffB); PG8_STAGE(PG8_SA(0, 0), a2, voffA);
            PG8_WAIT_R(); PG8_WAIT_L(0); PG8_BAR; PG8_MMA(1, 0, At, B0); PG8_MMA(1, 1, At, B1); PG8_BAR; PG8_SCHED;
#undef PG8_WAIT_R
            PG8_LDB(B0, 1, 0); PG8_LDB(B1, 1, 1); PG8_SCHED; PG8_LDA(At, 1, 0); PG8_STAGE(PG8_SA(0, 1), a2 + hstepA, voffA);
            PG8_WAIT_V(8); PG8_WAIT_L(0); PG8_BAR; PG8_MMA(0, 0, At, B0); PG8_MMA(0, 1, At, B1); PG8_BAR; PG8_SCHED;
            PG8_LDA(At, 1, 1); PG8_STAGE(PG8_SB(1, 0), b3, voffB); PG8_STAGE(PG8_SB(1, 1), b3 + hstepB, voffB); PG8_STAGE(PG8_SA(1, 0), a3, voffA);
            PG8_WAIT_V(8); PG8_WAIT_L(0); PG8_BAR; PG8_MMA(1, 0, At, B0); PG8_MMA(1, 1, At, B1); PG8_BAR; PG8_SCHED;
            } else {
            PG8_LDB(B0, 0, 0); PG8_SCHED; PG8_LDA(At, 0, 0); PG8_STAGE(PG8_SA(1, 1), a1 + hstepA, voffA);
            PG8_WAIT_L(8); PG8_BAR; PG8_WAIT_L(0); PG8_MMA(0, 0, At, B0); PG8_BAR; PG8_SCHED;
            PG8_LDB(B1, 0, 1); PG8_STAGE(PG8_SB(0, 0), b2, voffB);
            PG8_BAR; PG8_WAIT_L(0); PG8_MMA(0, 1, At, B1); PG8_BAR;
            PG8_LDA(At, 0, 1); PG8_STAGE(PG8_SA(0, 0), a2, voffA);
            PG8_BAR; PG8_WAIT_L(0); PG8_MMA(1, 0, At, B0); PG8_BAR; PG8_SCHED;
            PG8_STAGE(PG8_SB(0, 1), b2 + hstepB, voffB);
            PG8_WAIT_V(6); PG8_BAR; PG8_MMA(1, 1, At, B1); PG8_BAR;
            PG8_LDB(B0, 1, 0); PG8_SCHED; PG8_LDA(At, 1, 0); PG8_STAGE(PG8_SA(0, 1), a2 + hstepA, voffA);
            PG8_WAIT_L(8); PG8_BAR; PG8_WAIT_L(0); PG8_MMA(0, 0, At, B0); PG8_BAR; PG8_SCHED;
            PG8_LDB(B1, 1, 1); PG8_STAGE(PG8_SB(1, 0), b3, voffB);
            PG8_BAR; PG8_WAIT_L(0); PG8_MMA(0, 1, At, B1); PG8_BAR;
            PG8_LDA(At, 1, 1); PG8_STAGE(PG8_SA(1, 0), a3, voffA);
            PG8_BAR; PG8_WAIT_L(0); PG8_MMA(1, 0, At, B0); PG8_BAR; PG8_SCHED;
            PG8_STAGE(PG8_SB(1, 1), b3 + hstepB, voffB);
            PG8_WAIT_V(6); PG8_BAR; PG8_MMA(1, 1, At, B1); PG8_BAR;
            }
        }
        if constexpr (ALIGN_EPI) { if (wr == 0) PG8_BAR; }
        if constexpr (FP8) {
            asm volatile("s_nop 15\n\ts_nop 15" : "+v"(acc[0][0][0][0]), "+v"(acc[0][0][0][1]), "+v"(acc[0][0][1][0]), "+v"(acc[0][0][1][1]), "+v"(acc[0][0][2][0]), "+v"(acc[0][0][2][1]), "+v"(acc[0][0][3][0]), "+v"(acc[0][0][3][1]),
                         "+v"(acc[0][1][0][0]), "+v"(acc[0][1][0][1]), "+v"(acc[0][1][1][0]), "+v"(acc[0][1][1][1]), "+v"(acc[0][1][2][0]), "+v"(acc[0][1][2][1]), "+v"(acc[0][1][3][0]), "+v"(acc[0][1][3][1]));
            asm volatile("" : "+v"(acc[1][0][0][0]), "+v"(acc[1][0][0][1]), "+v"(acc[1][0][1][0]), "+v"(acc[1][0][1][1]), "+v"(acc[1][0][2][0]), "+v"(acc[1][0][2][1]), "+v"(acc[1][0][3][0]), "+v"(acc[1][0][3][1]),
                         "+v"(acc[1][1][0][0]), "+v"(acc[1][1][0][1]), "+v"(acc[1][1][1][0]), "+v"(acc[1][1][1][1]), "+v"(acc[1][1][2][0]), "+v"(acc[1][1][2][1]), "+v"(acc[1][1][3][0]), "+v"(acc[1][1][3][1])); }
        E(acc, cur, wr, wc, fr, fq);
        if (!has_next) break;
#pragma unroll
        for (int a = 0; a < 2; ++a)
#pragma unroll
            for (int b = 0; b < 2; ++b)
#pragma unroll
                for (int m = 0; m < 4; ++m)
#pragma unroll
                    for (int n = 0; n < 2; ++n) acc[a][b][m][n] = (f32x4){0.f, 0.f, 0.f, 0.f};
        cur = nxt; cA = nA; cB = nB; ++ui;
        if constexpr (ALIGN_EPI) { if (wr == 1) PG8_BAR; }
    }
    PG8_WAIT_V(0);
    if constexpr (!ALIGN_EPI) { if (wr == 0) PG8_BAR; }
    PG8_BAR;
#undef PG8_SA
#undef PG8_SB
#undef PG8_STAGE
#undef PG8_LDA
#undef PG8_LDB
#undef PG8_MMA
#undef PG8_LO
#undef PG8_HI
#undef PG8_WAIT_V
#undef PG8_WAIT_VN
#undef PG8_WAIT_L
#undef PG8_BAR
#undef PG8_SCHED
}
}
namespace att {
#define ATT_LAS __attribute__((address_space(3)))
typedef unsigned short bf16;
using bf16x8 = __attribute__((ext_vector_type(8))) short;
using s16x4  = __attribute__((ext_vector_type(4))) short;
using f32x16 = __attribute__((ext_vector_type(16))) float;
using u32x4  = __attribute__((ext_vector_type(4))) unsigned;
using i32x4  = __attribute__((ext_vector_type(4))) int;
using i32x8  = __attribute__((ext_vector_type(8))) int;
constexpr int NW = 8, QBLK = 32, KVBLK = 64;
constexpr int SHM_V = 16384, SHM_K = 16384, SHM_KR = 8192;
constexpr int OFF_V = 0, OFF_K = 2 * SHM_V, OFF_KR = OFF_K + 2 * SHM_K, OFF_WS = OFF_KR + 2 * SHM_KR, OFF_TAB = OFF_WS + NW * 64 * 4, ATT_LDS_BYTES = OFF_TAB + 15 * 128 * 4, OFF_OST = 98304  ;
constexpr float YS = 8.0f;
static_assert(ATT_LDS_BYTES <= OFF_OST, "attention LDS map");
#define KSWZ(row, colB) ((row) * 256 + ((colB) ^ (((row) & 7) << 4)))
#define KRSWZ(row, colB) ((row) * 128 + ((colB) ^ (((row) & 7) << 4)))
#define K8SWZ(row, colB) ((row) * 128 + ((colB) ^ ((((row) >> 1) & 7) << 4)))
#define SBAR() __builtin_amdgcn_sched_barrier(0)
__device__ __forceinline__ int crow(int r, int hi) { return (r & 3) + 8 * (r >> 2) + 4 * hi; }
__device__ __forceinline__ unsigned cvtpk(float lo, float hi) { unsigned r; asm volatile("v_cvt_pk_bf16_f32 %0, %1, %2" : "=v"(r) : "v"(lo), "v"(hi)); return r; }

template <int DQK> struct Sc { static constexpr float SCALE = (DQK == 192) ? 0.07216878364870322f : 0.08838834764831845f; };

template <int DQK, int F8>
__device__ __forceinline__ void partialSM(f32x16& p0, f32x16& p1, float& m_reg, float& mn, float& alpha) {
  constexpr float SCALE = Sc<DQK>::SCALE; constexpr float C = SCALE * 1.4426950408889634f; constexpr float THR = F8 ? 3.f : 8.f;
  float pmax = p0[0];
#pragma unroll
  for (int r = 1; r < 16; ++r) pmax = fmaxf(pmax, p0[r]);
#pragma unroll
  for (int r = 0; r < 16; ++r) pmax = fmaxf(pmax, p1[r]);
  { auto rr = __builtin_amdgcn_permlane32_swap(__float_as_uint(pmax), __float_as_uint(pmax), false, false);
    pmax = fmaxf(__uint_as_float(rr[0]), __uint_as_float(rr[1])); }
  if (__builtin_expect(__all(pmax - m_reg <= THR / SCALE), 1)) { mn = m_reg; alpha = 1.f; }
  else { mn = fmaxf(m_reg, pmax); alpha = __builtin_amdgcn_exp2f((m_reg - mn) * C); m_reg = mn; }
  float mnC = -mn * C + (F8 ? 4.f : 0.f);
#pragma unroll
  for (int r = 0; r < 16; ++r) p0[r] = fmaf(p0[r], C, mnC);
#pragma unroll
  for (int r = 0; r < 16; ++r) p1[r] = fmaf(p1[r], C, mnC);
#pragma unroll
  for (int r = 0; r < 16; ++r) p0[r] = __builtin_amdgcn_exp2f(p0[r]);
}
__device__ __forceinline__ void finishSM(f32x16& p0, f32x16& p1, float alpha, float& l_reg, bf16x8& pa0, bf16x8& pa1, bf16x8& pa2, bf16x8& pa3) {
#pragma unroll
  for (int r = 0; r < 16; ++r) p1[r] = __builtin_amdgcn_exp2f(p1[r]);
  float ps = 0;
#pragma unroll
  for (int r = 0; r < 16; ++r) ps += p0[r];
#pragma unroll
  for (int r = 0; r < 16; ++r) ps += p1[r];
  { auto rr = __builtin_amdgcn_permlane32_swap(__float_as_uint(ps), __float_as_uint(ps), false, false);
    ps = __uint_as_float(rr[0]) + __uint_as_float(rr[1]); }
  l_reg = l_reg * alpha + ps;
#define PK4(P, BASE, OUT) do { unsigned a0 = cvtpk(P[BASE + 0], P[BASE + 1]), a1 = cvtpk(P[BASE + 2], P[BASE + 3]);   \
    unsigned b0 = cvtpk(P[BASE + 4], P[BASE + 5]), b1 = cvtpk(P[BASE + 6], P[BASE + 7]);                              \
    auto r0 = __builtin_amdgcn_permlane32_swap(a0, b0, false, false); auto r1 = __builtin_amdgcn_permlane32_swap(a1, b1, false, false); \
    u32x4 w = {r0[0], r1[0], r0[1], r1[1]}; OUT = *reinterpret_cast<bf16x8*>(&w); } while (0)
  PK4(p0, 0, pa0); PK4(p0, 8, pa1); PK4(p1, 0, pa2); PK4(p1, 8, pa3);
#undef PK4
}
template <int DQK>
__device__ __forceinline__ void qkt(f32x16& p0, f32x16& p1, const ATT_LAS char* Ks, const ATT_LAS char* Krs, const bf16x8* qr, const ATT_LAS char* Qrs, int r32, int hi) {
  p0 = f32x16{}; p1 = f32x16{};
#pragma unroll
  for (int d0 = 0; d0 < 8; ++d0) { int cb = (d0 * 16 + hi * 8) * 2;
    bf16x8 b0 = *reinterpret_cast<const ATT_LAS bf16x8*>(Ks + KSWZ(r32, cb));
    bf16x8 b1 = *reinterpret_cast<const ATT_LAS bf16x8*>(Ks + KSWZ(32 + r32, cb));
    p0 = __builtin_amdgcn_mfma_f32_32x32x16_bf16(b0, qr[d0], p0, 0, 0, 0);
    p1 = __builtin_amdgcn_mfma_f32_32x32x16_bf16(b1, qr[d0], p1, 0, 0, 0); }
  if constexpr (DQK == 192) {
#pragma unroll
    for (int d0 = 0; d0 < 4; ++d0) { int cb = (d0 * 16 + hi * 8) * 2;
      bf16x8 b0 = *reinterpret_cast<const ATT_LAS bf16x8*>(Krs + KRSWZ(r32, cb));
      bf16x8 b1 = *reinterpret_cast<const ATT_LAS bf16x8*>(Krs + KRSWZ(32 + r32, cb));
      p0 = __builtin_amdgcn_mfma_f32_32x32x16_bf16(b0, qr[8 + d0], p0, 0, 0, 0);
      p1 = __builtin_amdgcn_mfma_f32_32x32x16_bf16(b1, qr[8 + d0], p1, 0, 0, 0); }
  }
}
#define KR8SWZ(row, c16) ((row) * 64 + ((((c16) ^ (((row) >> 2) & 3))) << 4))
template <int DQK>
__device__ __forceinline__ void qkt8(f32x16& p0, f32x16& p1, const ATT_LAS char* Ks, const ATT_LAS char* Krs, const i32x8 (&q8)[DQK / 64], int r32, int hi) {
  const int one = 0x7F7F7F7F;
#define LD32(dst, base, o0, o1) const i32x4 dst##_l = *reinterpret_cast<const ATT_LAS i32x4*>((base) + (o0)), dst##_h = *reinterpret_cast<const ATT_LAS i32x4*>((base) + (o1)); const i32x8 dst = __builtin_shufflevector(dst##_l, dst##_h, 0, 1, 2, 3, 4, 5, 6, 7)
  { const int cb = hi * 32;
    LD32(a0, Ks, K8SWZ(r32, cb), K8SWZ(r32, cb + 16)); LD32(a1, Ks, K8SWZ(32 + r32, cb), K8SWZ(32 + r32, cb + 16));
    asm volatile("v_mfma_scale_f32_32x32x64_f8f6f4 %0, %1, %2, 0, %3, %3 op_sel_hi:[0,0,0]" : "=&v"(p0) : "v"(a0), "v"(q8[0]), "v"(one));
    asm volatile("v_mfma_scale_f32_32x32x64_f8f6f4 %0, %1, %2, 0, %3, %3 op_sel_hi:[0,0,0]" : "=&v"(p1) : "v"(a1), "v"(q8[0]), "v"(one)); }
  { const int cb = 64 + hi * 32;
    LD32(a0, Ks, K8SWZ(r32, cb), K8SWZ(r32, cb + 16)); LD32(a1, Ks, K8SWZ(32 + r32, cb), K8SWZ(32 + r32, cb + 16));
    asm volatile("v_mfma_scale_f32_32x32x64_f8f6f4 %0, %1, %2, %0, %3, %3 op_sel_hi:[0,0,0]" : "+v"(p0) : "v"(a0), "v"(q8[1]), "v"(one));
    asm volatile("v_mfma_scale_f32_32x32x64_f8f6f4 %0, %1, %2, %0, %3, %3 op_sel_hi:[0,0,0]" : "+v"(p1) : "v"(a1), "v"(q8[1]), "v"(one)); }
  if constexpr (DQK == 192) {
    LD32(a0, Krs, KR8SWZ(r32, 2 * hi), KR8SWZ(r32, 2 * hi + 1)); LD32(a1, Krs, KR8SWZ(32 + r32, 2 * hi), KR8SWZ(32 + r32, 2 * hi + 1));
    asm volatile("v_mfma_scale_f32_32x32x64_f8f6f4 %0, %1, %2, %0, %3, %3 op_sel_hi:[0,0,0]" : "+v"(p0) : "v"(a0), "v"(q8[DQK / 64 - 1]), "v"(one));
    asm volatile("v_mfma_scale_f32_32x32x64_f8f6f4 %0, %1, %2, %0, %3, %3 op_sel_hi:[0,0,0]" : "+v"(p1) : "v"(a1), "v"(q8[DQK / 64 - 1]), "v"(one)); }
#undef LD32
  asm volatile("s_nop 15\n\ts_nop 7" : "+v"(p0), "+v"(p1));
}
__device__ __forceinline__ int v_st(int k, int c) { const int kk = (k & ~0xC) | ((k & 4) << 1) | ((k & 8) >> 1); return ((kk >> 3) * 4 + (c >> 5)) * 512 + ((kk & 7) * 32 + (c & 31)) * 2; }
__device__ __forceinline__ int v_rd_base(int lane) { return ((lane & 3) << 3) | (((lane >> 2) & 3) << 6) | (((lane >> 4) & 1) << 5) | (((lane >> 5) & 1) << 8); }
constexpr int v_rd_off(int d0, int ks, int half) { return d0 * 512 + ks * 4096 + half * 2048; }
template <int OFF> __device__ __forceinline__ s16x4 tr_read(int vb) {
  s16x4 r; asm volatile("ds_read_b64_tr_b16 %0, %1 offset:%2" : "=&v"(r) : "v"(vb), "i"(OFF) : "memory"); return r;
}
template <int D0> __device__ __forceinline__ void pv_one(f32x16& od, int vb, bf16x8 pa0, bf16x8 pa1, bf16x8 pa2, bf16x8 pa3) {
  const s16x4 l0 = tr_read<v_rd_off(D0, 0, 0)>(vb), h0 = tr_read<v_rd_off(D0, 0, 1)>(vb), l1 = tr_read<v_rd_off(D0, 1, 0)>(vb), h1 = tr_read<v_rd_off(D0, 1, 1)>(vb);
  const s16x4 l2 = tr_read<v_rd_off(D0, 2, 0)>(vb), h2 = tr_read<v_rd_off(D0, 2, 1)>(vb), l3 = tr_read<v_rd_off(D0, 3, 0)>(vb), h3 = tr_read<v_rd_off(D0, 3, 1)>(vb);
  asm volatile("s_waitcnt lgkmcnt(0)" ::: "memory"); SBAR();
#define PK(L, H) (bf16x8){L[0], L[1], L[2], L[3], H[0], H[1], H[2], H[3]}
  od = __builtin_amdgcn_mfma_f32_32x32x16_bf16(pa0, PK(l0, h0), od, 0, 0, 0);
  od = __builtin_amdgcn_mfma_f32_32x32x16_bf16(pa1, PK(l1, h1), od, 0, 0, 0);
  od = __builtin_amdgcn_mfma_f32_32x32x16_bf16(pa2, PK(l2, h2), od, 0, 0, 0);
  od = __builtin_amdgcn_mfma_f32_32x32x16_bf16(pa3, PK(l3, h3), od, 0, 0, 0);
#undef PK
}
__device__ __forceinline__ void pv_d0(f32x16* o, int vb, bf16x8 pa0, bf16x8 pa1, bf16x8 pa2, bf16x8 pa3) {
  pv_one<0>(o[0], vb, pa0, pa1, pa2, pa3); pv_one<1>(o[1], vb, pa0, pa1, pa2, pa3); pv_one<2>(o[2], vb, pa0, pa1, pa2, pa3); pv_one<3>(o[3], vb, pa0, pa1, pa2, pa3);
}

__device__ __forceinline__ void finishSM8(f32x16& p0, f32x16& p1, float alpha, float& l_reg, i32x8& P8) {
#pragma unroll
  for (int r = 0; r < 16; ++r) p1[r] = __builtin_amdgcn_exp2f(p1[r]);
  float ps = 0;
#pragma unroll
  for (int r = 0; r < 16; ++r) ps += p0[r];
#pragma unroll
  for (int r = 0; r < 16; ++r) ps += p1[r];
  { auto rr = __builtin_amdgcn_permlane32_swap(__float_as_uint(ps), __float_as_uint(ps), false, false);
    ps = __uint_as_float(rr[0]) + __uint_as_float(rr[1]); }
  l_reg = l_reg * alpha + ps;
  int w[8];
#pragma unroll
  for (int k = 0; k < 4; ++k) { int x = 0; x = __builtin_amdgcn_cvt_pk_fp8_f32(p0[4 * k], p0[4 * k + 1], x, false); x = __builtin_amdgcn_cvt_pk_fp8_f32(p0[4 * k + 2], p0[4 * k + 3], x, true); w[k] = x;
    int y = 0; y = __builtin_amdgcn_cvt_pk_fp8_f32(p1[4 * k], p1[4 * k + 1], y, false); y = __builtin_amdgcn_cvt_pk_fp8_f32(p1[4 * k + 2], p1[4 * k + 3], y, true); w[4 + k] = y; }
  P8 = (i32x8){w[0], w[1], w[2], w[3], w[4], w[5], w[6], w[7]};
}
using u32x2 = __attribute__((ext_vector_type(2))) unsigned;
template <int OFF> __device__ __forceinline__ u32x2 tr8_read(int vb) {
  u32x2 r; asm volatile("ds_read_b64_tr_b8 %0, %1 offset:%2" : "=&v"(r) : "v"(vb), "i"(OFF) : "memory"); return r;
}
template <bool LAST> __device__ __forceinline__ void pv8_one(f32x16& od, int vb, const i32x8& P8) {
  const u32x2 r0 = tr8_read<0>(vb), r1 = tr8_read<2048>(vb), r2 = tr8_read<4096>(vb), r3 = tr8_read<6144>(vb);
  asm volatile("s_waitcnt lgkmcnt(0)" ::: "memory"); SBAR();
  const i32x8 vf = (i32x8){(int)r0.x, (int)r0.y, (int)r1.x, (int)r1.y, (int)r2.x, (int)r2.y, (int)r3.x, (int)r3.y};
  const int one = 0x7F7F7F7F;
  asm volatile("v_mfma_scale_f32_32x32x64_f8f6f4 %0, %1, %2, %0, %3, %3 op_sel_hi:[0,0,0]" : "+v"(od) : "v"(P8), "v"(vf), "v"(one));
}
__device__ __forceinline__ void pv8(f32x16* o, const int (&vb)[4], int boff, const i32x8& P8) {
  pv8_one<false>(o[0], vb[0] + boff, P8); pv8_one<false>(o[1], vb[1] + boff, P8); pv8_one<false>(o[2], vb[2] + boff, P8); pv8_one<true>(o[3], vb[3] + boff, P8);
  asm volatile("s_nop 15\n\ts_nop 7" : "+v"(o[0]), "+v"(o[1]), "+v"(o[2]), "+v"(o[3]));
}


#define ATT_LD32(dst, base, o0, o1) const i32x4 dst##_l = *reinterpret_cast<const ATT_LAS i32x4*>((base) + (o0)), dst##_h = *reinterpret_cast<const ATT_LAS i32x4*>((base) + (o1)); const i32x8 dst = __builtin_shufflevector(dst##_l, dst##_h, 0, 1, 2, 3, 4, 5, 6, 7)
#define ATT_MF0(ACC, A_, B_, TIE) asm volatile("v_mfma_scale_f32_32x32x64_f8f6f4 %0, %2, %3, 0, %4, %4 op_sel_hi:[0,0,0]" : "=&v"(ACC), "+v"(TIE) : "v"(A_), "v"(B_), "v"(one) : "memory")
#define ATT_MF1(ACC, A_, B_, TIE) asm volatile("v_mfma_scale_f32_32x32x64_f8f6f4 %0, %2, %3, %0, %4, %4 op_sel_hi:[0,0,0]" : "+v"(ACC), "+v"(TIE) : "v"(A_), "v"(B_), "v"(one) : "memory")
#define ATT_MF2(ACC, A_, B_, T0, T1) asm volatile("v_mfma_scale_f32_32x32x64_f8f6f4 %0, %3, %4, %0, %5, %5 op_sel_hi:[0,0,0]" : "+v"(ACC), "+v"(T0), "+v"(T1) : "v"(A_), "v"(B_), "v"(one))
template <int A, int B> __device__ __forceinline__ void exp_rng(f32x16& p) {
#pragma unroll
  for (int r = A; r < B; ++r) p[r] = __builtin_amdgcn_exp2f(p[r]);
}
template <int DQK>
__device__ __forceinline__ void fusedA(f32x16& n0, f32x16& n1, const ATT_LAS char* Ks, const ATT_LAS char* Krs, const i32x8 (&q8)[DQK / 64], int r32, int hi, f32x16& pp0, f32x16& pp1, float alp, float& l_reg, i32x8& P8) {
  const int one = 0x7F7F7F7F;
  const int cb = hi * 32, cc = 64 + hi * 32;
  ATT_LD32(a0, Ks, K8SWZ(r32, cb), K8SWZ(r32, cb + 16)); ATT_LD32(a1, Ks, K8SWZ(32 + r32, cb), K8SWZ(32 + r32, cb + 16));
  if constexpr (DQK == 192) {
    ATT_MF0(n0, a0, q8[0], pp1); ATT_LD32(b0, Ks, K8SWZ(r32, cc), K8SWZ(r32, cc + 16)); exp_rng<0, 3>(pp1);
    ATT_MF0(n1, a1, q8[0], pp1); ATT_LD32(b1, Ks, K8SWZ(32 + r32, cc), K8SWZ(32 + r32, cc + 16)); exp_rng<3, 6>(pp1);
    ATT_MF1(n0, b0, q8[1], pp1); ATT_LD32(c0, Krs, KR8SWZ(r32, 2 * hi), KR8SWZ(r32, 2 * hi + 1)); exp_rng<6, 9>(pp1);
    ATT_MF1(n1, b1, q8[1], pp1); ATT_LD32(c1, Krs, KR8SWZ(32 + r32, 2 * hi), KR8SWZ(32 + r32, 2 * hi + 1)); exp_rng<9, 12>(pp1);
    ATT_MF1(n0, c0, q8[2], pp1); exp_rng<12, 14>(pp1);
    ATT_MF1(n1, c1, q8[2], pp1); exp_rng<14, 16>(pp1);
  } else {
    ATT_MF0(n0, a0, q8[0], pp1); ATT_LD32(b0, Ks, K8SWZ(r32, cc), K8SWZ(r32, cc + 16)); exp_rng<0, 4>(pp1);
    ATT_MF0(n1, a1, q8[0], pp1); ATT_LD32(b1, Ks, K8SWZ(32 + r32, cc), K8SWZ(32 + r32, cc + 16)); exp_rng<4, 8>(pp1);
    ATT_MF1(n0, b0, q8[1], pp1); exp_rng<8, 12>(pp1);
    ATT_MF1(n1, b1, q8[1], pp1); exp_rng<12, 16>(pp1);
  }
  typedef float f32x2_ __attribute__((ext_vector_type(2)));
  f32x2_ ps2 = {pp0[0], pp0[1]};
#pragma unroll
  for (int r = 2; r < 16; r += 2) ps2 += (f32x2_){pp0[r], pp0[r + 1]};
#pragma unroll
  for (int r = 0; r < 16; r += 2) ps2 += (f32x2_){pp1[r], pp1[r + 1]};
  float ps = ps2.x + ps2.y;
  { auto rr = __builtin_amdgcn_permlane32_swap(__float_as_uint(ps), __float_as_uint(ps), false, false);
    ps = __uint_as_float(rr[0]) + __uint_as_float(rr[1]); }
  l_reg = l_reg * alp + ps;
  int w[8];
#pragma unroll
  for (int k = 0; k < 4; ++k) { int x = 0; x = __builtin_amdgcn_cvt_pk_fp8_f32(pp0[4 * k], pp0[4 * k + 1], x, false); x = __builtin_amdgcn_cvt_pk_fp8_f32(pp0[4 * k + 2], pp0[4 * k + 3], x, true); w[k] = x;
    int y = 0; y = __builtin_amdgcn_cvt_pk_fp8_f32(pp1[4 * k], pp1[4 * k + 1], y, false); y = __builtin_amdgcn_cvt_pk_fp8_f32(pp1[4 * k + 2], pp1[4 * k + 3], y, true); w[4 + k] = y; }
  P8 = (i32x8){w[0], w[1], w[2], w[3], w[4], w[5], w[6], w[7]};
}
struct AttnUnit {
  const bf16* Q; int ldq;
  const bf16* Kn; int ldkv;
  const bf16* Kr; int ldkr;
  const bf16* V;
  const unsigned char* K8; int ldk8;
  const unsigned char* Kr8;
  const unsigned char* V8; int ldv8;
  bf16* O; int ldo;
  int NT, n0, base0, base1;
  const float* rpb;
  int qrow0, krow0;
};

template <int DQK, int MODE, int K8, int Q8 = 0>
__device__ __forceinline__ void attn_body(const AttnUnit& U, ATT_LAS char* lds, const AttnUnit& N, bool has_next, bool pre) {
  constexpr float SCALE = Sc<DQK>::SCALE; constexpr int NQR = DQK / 16;
  int tid_ = threadIdx.x; asm volatile("" : "+v"(tid_));
  const int tid = tid_, wid = __builtin_amdgcn_readfirstlane(tid >> 6), lane = tid & 63, r32 = lane & 31, hi = lane >> 5;
  ATT_LAS char* V_lds = lds + OFF_V; ATT_LAS char* K_lds = lds + OFF_K; ATT_LAS char* KR_lds = lds + OFF_KR;
  ATT_LAS float* ws = (ATT_LAS float*)(lds + OFF_WS) + wid * 64; ATT_LAS float* li_l = ws; ATT_LAS float* al_l = ws + 32;
  ATT_LAS float* tab = (ATT_LAS float*)(lds + OFF_TAB);
  float m_reg = -1e30f, l_reg = 0; f32x16 o[4] = {}; bf16x8 qr[K8 ? 1 : NQR]; i32x8 q8[DQK / 64];
  if constexpr (K8 && Q8) {
    const unsigned char* Qb = (const unsigned char*)U.Q + (size_t)(wid * QBLK + r32) * U.ldq * 2 + hi * 32;
#pragma unroll
    for (int s = 0; s < DQK / 64; ++s) { const i32x4 lo = *reinterpret_cast<const i32x4*>(Qb + s * 64), hi_ = *reinterpret_cast<const i32x4*>(Qb + s * 64 + 16); q8[s] = __builtin_shufflevector(lo, hi_, 0, 1, 2, 3, 4, 5, 6, 7); }
  } else if constexpr (K8) {
    const bf16* Qw8 = U.Q + (long)(wid * QBLK + r32) * U.ldq + hi * 32;
#pragma unroll
    for (int s = 0; s < DQK / 64; ++s) { int w[8];
#pragma unroll
      for (int j = 0; j < 4; ++j) { const u32x4 x = *reinterpret_cast<const u32x4*>(Qw8 + s * 64 + j * 8);
        int lo = 0, hi_ = 0;
        lo = __builtin_amdgcn_cvt_pk_fp8_f32(__uint_as_float(x.x << 16), __uint_as_float(x.x & 0xffff0000u), lo, false); lo = __builtin_amdgcn_cvt_pk_fp8_f32(__uint_as_float(x.y << 16), __uint_as_float(x.y & 0xffff0000u), lo, true);
        hi_ = __builtin_amdgcn_cvt_pk_fp8_f32(__uint_as_float(x.z << 16), __uint_as_float(x.z & 0xffff0000u), hi_, false); hi_ = __builtin_amdgcn_cvt_pk_fp8_f32(__uint_as_float(x.w << 16), __uint_as_float(x.w & 0xffff0000u), hi_, true);
        w[2 * j] = lo; w[2 * j + 1] = hi_; }
      q8[s] = (i32x8){w[0], w[1], w[2], w[3], w[4], w[5], w[6], w[7]}; }
  } else {
    const bf16* Qw = U.Q + (long)(wid * QBLK + r32) * U.ldq + hi * 8;
#pragma unroll
    for (int d0 = 0; d0 < NQR; ++d0) qr[d0] = *reinterpret_cast<const bf16x8*>(Qw + d0 * 16);
  }
  const ATT_LAS char* Qrs = lds + OFF_OST + wid * 4096;
  const int vb0 = (int)(unsigned)(__UINTPTR_TYPE__)V_lds + v_rd_base(lane);
  const int kRow = tid >> 4, voK = kRow * U.ldkv + (((tid & 15) ^ (kRow & 7)) << 3);
  const int vkk = ((tid >> 7) << 3) + ((tid >> 2) & 7), vk = (vkk & ~0xC) | ((vkk & 4) << 1) | ((vkk & 8) >> 1), voV = vk * U.ldkv + ((tid >> 5) & 3) * 32 + (tid & 3) * 8;
  const int rRow = tid >> 3, voR = rRow * U.ldkr + (((tid & 7) ^ (rRow & 7)) << 3);
  const int voK8 = rRow * U.ldk8 + (((tid & 7) ^ ((rRow >> 1) & 7)) << 4);
  const int r8Row = (tid & 255) >> 2, voR8 = r8Row * 64 + (((tid & 3) ^ ((r8Row >> 2) & 3)) << 4);
  const unsigned wls = (unsigned)wid * 1024u;
  const int vKey = tid >> 3, voV8 = vKey * U.ldv8 + ((((tid & 7) ^ ((vKey & 3) | (((vKey >> 3) & 1) << 2)))) << 4);
  int vb8[4];
  { const int i16 = lane & 15, r_ = i16 >> 1, c_ = i16 & 1, gpar = (lane >> 4) & 1, key0 = 8 * (r_ >> 2) + 4 * hi + (r_ & 3);
#pragma unroll
    for (int d0 = 0; d0 < 4; ++d0) vb8[d0] = (int)(unsigned)(__UINTPTR_TYPE__)V_lds + key0 * 128 + (((2 * d0 + gpar) ^ r_) << 4) + 8 * c_; }
  int na_qrow = 0, na_rs = 0, na_lo = 0, na_tb = 0;
  if constexpr (MODE == 1) {
    for (int i = tid; i < 15 * 128; i += 512) { const int dr = i >> 7, x = (i & 127) - 48; tab[i] = (x >= 0 && x < 31) ? U.rpb[dr * 31 + x] * (1.0f / SCALE) : 0.f; }
    na_qrow = U.qrow0 + (wid >> 1);
    const int c = 32 * (wid & 1) + r32; int cs = c - 8; cs = cs < 0 ? 0 : (cs > 48 ? 48 : cs);
    na_rs = na_qrow - 4; na_rs = na_rs < 0 ? 0 : (na_rs > 24 ? 24 : na_rs);
    na_lo = cs - 4 * hi;
    na_tb = 63 - c + 4 * hi;
  }
  auto krow = [&](int j) -> long { return (j < U.n0) ? (long)U.base0 + 64 * j : (long)U.base1 + 64 * (j - U.n0); };
#define DMA16(g, l) __builtin_amdgcn_global_load_lds((const unsigned*)(g), (ATT_LAS unsigned*)(l), 16, 0, 0)
#define ISSUE_K(j, b) do { const long _k0 = krow(j); if constexpr (K8) { DMA16(U.K8 + _k0 * U.ldk8 + voK8, K_lds + (b) * SHM_K + wls); if constexpr (DQK == 192) DMA16(U.Kr8 + _k0 * 64 + voR8, KR_lds + (b) * SHM_KR + (wls & 3072u)); } else { const bf16* _kp = U.Kn + _k0 * U.ldkv; \
    DMA16(_kp + voK, K_lds + (b) * SHM_K + wls); DMA16(_kp + 32 * U.ldkv + voK, K_lds + (b) * SHM_K + wls + 8192); } \
    if constexpr (DQK == 192 && !K8) { const bf16* _rp = U.Kr + _k0 * U.ldkr; DMA16(_rp + voR, KR_lds + (b) * SHM_KR + wls); } } while (0)
#define ISSUE_V(j, b) do { const long _k0 = krow(j); if constexpr (K8) { DMA16(U.V8 + _k0 * U.ldv8 + voV8, V_lds + (b) * SHM_V + wls); } else { const bf16* _vp = U.V + _k0 * U.ldkv; \
    DMA16(_vp + voV, V_lds + (b) * SHM_V + wls); DMA16(_vp + 32 * U.ldkv + voV, V_lds + (b) * SHM_V + wls + 8192); } } while (0)
#define WAITNV() do { if constexpr (K8) WAITV(1); else WAITV(2); } while (0)
#define WAITV(n) asm volatile("s_waitcnt vmcnt(" #n ")" ::: "memory")
#define BAR() do { asm volatile("" ::: "memory"); __builtin_amdgcn_s_barrier(); asm volatile("" ::: "memory"); } while (0)
#define RESC(a) do { if (__any((a) < 1.f)) { if (hi == 0) al_l[r32] = (a); asm volatile("s_waitcnt lgkmcnt(0)" ::: "memory"); \
    asm volatile("s_nop 15\n\ts_nop 7" : "+v"(o[0]), "+v"(o[1]), "+v"(o[2]), "+v"(o[3]));        \
    _Pragma("unroll") for (int d = 0; d < 4; ++d) _Pragma("unroll") for (int r = 0; r < 16; ++r) o[d][r] *= al_l[crow(r, hi)]; } } while (0)
#define NAHOOK(P0, P1, j) do { if constexpr (MODE == 1) { if ((j) >= U.n0) { \
      const int _kr = U.krow0 + ((j) - U.n0); const bool _rv = (_kr >= na_rs) && (_kr < na_rs + 8); \
      int _dr = _kr - na_qrow + 7; _dr = _dr < 0 ? 0 : (_dr > 14 ? 14 : _dr); \
      const ATT_LAS float* _t = tab + _dr * 128 + na_tb; \
      _Pragma("unroll") for (int r = 0; r < 16; ++r) { const int kc0 = (r & 3) + 8 * (r >> 2); \
        const bool v0 = _rv && ((unsigned)(kc0 - na_lo) < 16u); const bool v1 = _rv && ((unsigned)(kc0 + 32 - na_lo) < 16u); \
        P0[r] = v0 ? P0[r] + _t[kc0] : -1e30f; P1[r] = v1 ? P1[r] + _t[kc0 + 32] : -1e30f; } } } } while (0)
  f32x16 pA0, pA1, pB0, pB1; float mnA = 0.f, mnB = 0.f, alA = 1.f, alB = 1.f; bf16x8 pa0, pa1, pa2, pa3; i32x8 P8; const int NT = U.NT;
  auto live = [&](int j) -> bool { if constexpr (MODE == 1) { if (j >= U.n0) { const int kr_ = U.krow0 + (j - U.n0); return (kr_ >= na_rs) && (kr_ < na_rs + 8); } } return true; };
#define QKT(P0, P1, KB, KRB) do { if constexpr (K8) qkt8<DQK>(P0, P1, KB, KRB, q8, r32, hi); else qkt<DQK>(P0, P1, KB, KRB, qr, Qrs, r32, hi); } while (0)
#define FINPV(PP0, PP1, ALP, VB) do { if constexpr (K8) { finishSM8(PP0, PP1, ALP, l_reg, P8); SBAR(); pv8(o, vb8, (VB) - vb0, P8); } else { finishSM(PP0, PP1, ALP, l_reg, pa0, pa1, pa2, pa3); SBAR(); pv_d0(o, VB, pa0, pa1, pa2, pa3); } } while (0)
#define TRBLK(X, D0, VBO) const u32x2 X##0 = tr8_read<0>(vb8[D0] + (VBO)), X##1 = tr8_read<2048>(vb8[D0] + (VBO)), X##2 = tr8_read<4096>(vb8[D0] + (VBO)), X##3 = tr8_read<6144>(vb8[D0] + (VBO))
#define TRVF(X) (i32x8){(int)(X##0).x, (int)(X##0).y, (int)(X##1).x, (int)(X##1).y, (int)(X##2).x, (int)(X##2).y, (int)(X##3).x, (int)(X##3).y}
#define FUSED_B(PS0, PS1, js, MNS, ALS, VBO) do { const int one = 0x7F7F7F7F; constexpr float C_ = SCALE * 1.4426950408889634f; \
    TRBLK(x_, 0, VBO); TRBLK(y_, 1, VBO); asm volatile("s_waitcnt lgkmcnt(4)" ::: "memory"); \
    { const i32x8 vf = TRVF(x_); ATT_MF2(o[0], P8, vf, PS0, PS1); } \
    NAHOOK(PS0, PS1, js); \
    float pmax_ = PS0[0]; \
    _Pragma("unroll") for (int r = 1; r < 16; ++r) pmax_ = fmaxf(pmax_, PS0[r]); \
    _Pragma("unroll") for (int r = 0; r < 16; ++r) pmax_ = fmaxf(pmax_, PS1[r]); \
    { auto rr = __builtin_amdgcn_permlane32_swap(__float_as_uint(pmax_), __float_as_uint(pmax_), false, false); pmax_ = fmaxf(__uint_as_float(rr[0]), __uint_as_float(rr[1])); } \
    if (__builtin_expect(__all(pmax_ - m_reg <= 3.f / SCALE), 1)) { MNS = m_reg; ALS = 1.f; } \
    else { MNS = fmaxf(m_reg, pmax_); ALS = __builtin_amdgcn_exp2f((m_reg - MNS) * C_); m_reg = MNS; } \
    const float mnC_ = -MNS * C_ + 4.f; \
    TRBLK(z_, 2, VBO); asm volatile("s_waitcnt lgkmcnt(4)" ::: "memory"); \
    { const i32x8 vf = TRVF(y_); ATT_MF2(o[1], P8, vf, PS0, PS1); } \
    _Pragma("unroll") for (int r = 0; r < 16; ++r) PS0[r] = fmaf(PS0[r], C_, mnC_); \
    _Pragma("unroll") for (int r = 0; r < 16; ++r) PS1[r] = fmaf(PS1[r], C_, mnC_); \
    TRBLK(u_, 3, VBO); asm volatile("s_waitcnt lgkmcnt(4)" ::: "memory"); \
    { const i32x8 vf = TRVF(z_); ATT_MF2(o[2], P8, vf, PS0, PS1); } \
    exp_rng<0, 4>(PS0); \
    asm volatile("s_waitcnt lgkmcnt(0)" ::: "memory"); \
    { const i32x8 vf = TRVF(u_); ATT_MF2(o[3], P8, vf, PS0, PS1); } \
    exp_rng<4, 16>(PS0); } while (0)
#define HALF_STEP(PS0, PS1, KB, KRB, js, MNS, ALS, PP0, PP1, ALP, VB, jp) do { const bool ls_ = live(js), lp_ = live(jp); bool fz_ = false; if constexpr (K8 && MODE == 0) fz_ = ls_ && lp_; \
    if (fz_) { if constexpr (K8 && MODE == 0) { SBAR(); fusedA<DQK>(PS0, PS1, KB, KRB, q8, r32, hi, PP0, PP1, ALP, l_reg, P8); FUSED_B(PS0, PS1, js, MNS, ALS, (VB) - vb0); } } \
    else { \
    if (ls_) { SBAR(); QKT(PS0, PS1, KB, KRB); } \
    if (lp_) { FINPV(PP0, PP1, ALP, VB); } \
    if (ls_) { NAHOOK(PS0, PS1, js); partialSM<DQK, K8>(PS0, PS1, m_reg, MNS, ALS); } else { ALS = 1.f; } } } while (0)
  WAITV(0);
  if (!pre) { ISSUE_K(0, 0); ISSUE_V(0, 0); ISSUE_K(1, 1);
    if constexpr (K8) { if constexpr (DQK == 192) WAITV(2); else WAITV(1); } else { if constexpr (DQK == 192) WAITV(3); else WAITV(2); } }
  asm volatile("s_waitcnt lgkmcnt(0)" ::: "memory"); BAR();
  QKT(pA0, pA1, K_lds, KR_lds); NAHOOK(pA0, pA1, 0); partialSM<DQK, K8>(pA0, pA1, m_reg, mnA, alA);
  ISSUE_V(1, 1);
  WAITNV(); BAR();
  for (int j = 1; j + 1 < NT; j += 2) {
    ISSUE_K(j + 1, 0);
    HALF_STEP(pB0, pB1, K_lds + SHM_K, KR_lds + SHM_KR, j, mnB, alB, pA0, pA1, alA, vb0, j - 1);
    BAR();
    ISSUE_V(j + 1, 0);
    RESC(alB);
    WAITNV(); BAR();
    ISSUE_K(j + 2, 1);
    HALF_STEP(pA0, pA1, K_lds, KR_lds, j + 1, mnA, alA, pB0, pB1, alB, vb0 + SHM_V, j);
    BAR();
    ISSUE_V(j + 2, 1);
    RESC(alA);
    WAITNV(); BAR();
  }
  HALF_STEP(pB0, pB1, K_lds + SHM_K, KR_lds + SHM_KR, NT - 1, mnB, alB, pA0, pA1, alA, vb0, NT - 2);
  RESC(alB);
  WAITV(0); BAR();
  if constexpr (K8) { if (has_next) {
      const int nK = rRow * N.ldk8 + (((tid & 7) ^ ((rRow >> 1) & 7)) << 4), nV = vKey * N.ldv8 + ((((tid & 7) ^ ((vKey & 3) | (((vKey >> 3) & 1) << 2)))) << 4);
      const long k0_ = (0 < N.n0) ? (long)N.base0 : (long)N.base1, k1_ = (1 < N.n0) ? (long)N.base0 + 64 : (long)N.base1 + 64 * (1 - N.n0);
      DMA16(N.K8 + k0_ * N.ldk8 + nK, K_lds + wls); if constexpr (DQK == 192) DMA16(N.Kr8 + k0_ * 64 + voR8, KR_lds + (wls & 3072u));
      DMA16(N.V8 + k0_ * N.ldv8 + nV, V_lds + wls);
      DMA16(N.K8 + k1_ * N.ldk8 + nK, K_lds + SHM_K + wls); if constexpr (DQK == 192) DMA16(N.Kr8 + k1_ * 64 + voR8, KR_lds + SHM_KR + (wls & 3072u)); } }
  if (live(NT - 1)) { FINPV(pB0, pB1, alB, vb0 + SHM_V); }
  int le_ = lane; asm volatile("" : "+v"(le_)); const int r32e = le_ & 31, hie = le_ >> 5;
  if (hie == 0) li_l[r32e] = l_reg; asm volatile("s_waitcnt lgkmcnt(0)" ::: "memory");
  float rli[16];
#pragma unroll
  for (int r = 0; r < 16; ++r) rli[r] = __builtin_amdgcn_rcpf(li_l[crow(r, hie)]) * YS;
  { ATT_LAS unsigned char* st = (ATT_LAS unsigned char*)(lds + OFF_OST) + wid * 4096;
#pragma unroll
    for (int r = 0; r < 16; ++r) { const int orow = crow(r, hie);
#pragma unroll
      for (int d0 = 0; d0 < 4; ++d0) { const int w = __builtin_amdgcn_cvt_pk_fp8_f32(o[d0][r] * rli[r], 0.f, 0, false); st[orow * 128 + d0 * 32 + r32e] = (unsigned char)w; } }
    asm volatile("s_waitcnt lgkmcnt(0)" ::: "memory");
    unsigned char* Ob = (unsigned char*)U.O + (size_t)(wid * QBLK) * U.ldo * 2 + (le_ & 7) * 16;
#pragma unroll
    for (int i = 0; i < 4; ++i) { const int row = (le_ >> 3) + 8 * i; const u32x4 w = *(const ATT_LAS u32x4*)(st + row * 128 + (le_ & 7) * 16);
      *(u32x4*)(Ob + (size_t)row * U.ldo * 2) = w; }
    asm volatile("s_waitcnt lgkmcnt(0)" ::: "memory"); }
  BAR();
#undef HALF_STEP
#undef FUSED_B
#undef TRBLK
#undef TRVF
#undef FINPV
#undef WAITNV
#undef QKT
#undef DMA16
#undef ISSUE_K
#undef ISSUE_V
#undef WAITV
#undef BAR
#undef RESC
#undef NAHOOK
}
}
constexpr int NB = 8, SEQ = 2048, CTXL = 256, D = 2048, TPB = SEQ + CTXL  , M = NB * TPB  ;
constexpr int DEPTH = 2;
constexpr int N_IN = 19008, NP = 19200  , LDP = 21248  , C_YA = 19200;
constexpr int C_MQ = 0, C_CKV = 3072, C_KR = 3584, C_NQ = 3648, C_NK = 5696, C_NV = 7744, C_GQ = 9792, C_GK = 11840, C_GV = 12352, C_GATE = 12864;
constexpr int KVR = 512, KVW = 4096, DFF = 5632, DFF2 = 11264, ADA = 12288;
constexpr float ALPHA = 1.4142135623730951f, ADA_EPS = 1e-6f, POST_EPS = 1e-5f, RMS_EPS = 1e-6f;
constexpr size_t MiB = 1u << 20;
constexpr size_t WS_CTL = 0, CTL_ZERO_BYTES = 64 * 1024;
constexpr size_t WS_MFIN = 1 * MiB, WS_MPART = 2 * MiB, WS_XCTX = 16 * MiB, WS_C = 32 * MiB, WS_KRR = 50 * MiB;
constexpr size_t WS_WIN = 53 * MiB, WS_WUKV = 128 * MiB, WS_WBR = 132 * MiB, WS_WOUT = 156 * MiB, WS_WUP = 164 * MiB, WS_WDN = 208 * MiB;
constexpr size_t WS_KV = 230 * MiB, WS_P = 374 * MiB, WS_KN8 = 1121 * MiB  , WS_END = 1157 * MiB;
constexpr size_t WS_KM8 = WS_KV  , WS_VM8 = WS_KV + 36 * MiB  , WS_VN8 = WS_KV + 72 * MiB  , WS_VG8 = WS_KV + 108 * MiB  ;
constexpr size_t WS_KG8 = WS_MPART;
constexpr size_t WS_ACC = WS_KV, WS_ACC8 = WS_KV + 72 * MiB  , WS_H2 = WS_KV + 72 * MiB, WS_FOUT = WS_KV;
constexpr size_t WS_YOUT = WS_P, WS_SBG = WS_P  , WS_SBV = WS_P + 16 * MiB  , WS_A = WS_P + 396 * MiB;
static_assert(WS_WIN + (size_t)NP * D * 2 <= WS_WUKV && WS_KV + (size_t)M * KVW * 2 <= WS_P && WS_P + (size_t)M * LDP * 2 <= WS_KN8 && WS_KN8 + (size_t)M * 2048 <= WS_END && WS_KG8 + (size_t)M * 512 <= WS_XCTX && WS_A + (size_t)M * DFF * 2 <= WS_END && (size_t)M * DFF2 * 2 <= 396 * MiB, "ws map");
constexpr int CW_BAR = 4096;
constexpr int RING_BYTES = 131072, LDSCTL_OFF = RING_BYTES, MISC_OFF = LDSCTL_OFF + 320, LDS_BYTES = 147456;
constexpr int NWAVES = 8;

#define GAS __attribute__((address_space(1)))
#define LAS __attribute__((address_space(3)))
typedef unsigned short bf16;
typedef unsigned v4u __attribute__((ext_vector_type(4)));
typedef unsigned v2u __attribute__((ext_vector_type(2)));
typedef float f32x4 __attribute__((ext_vector_type(4)));
#define LDS_WAIT() asm volatile("s_waitcnt lgkmcnt(0)" ::: "memory")
__device__ __forceinline__ unsigned f2bf(float f) { unsigned u = __builtin_bit_cast(unsigned, f); return (u + 0x7fffu + ((u >> 16) & 1u)) >> 16; }
__device__ __forceinline__ unsigned pk2(float lo, float hi) { return f2bf(lo) | (f2bf(hi) << 16); }
__device__ __forceinline__ float bf2f(unsigned short b) { return __uint_as_float(((unsigned)b) << 16); }
__device__ __forceinline__ float wave_sum(float v) {
#pragma unroll
    for (int o = 1; o < 64; o <<= 1) v += __shfl_xor(v, o);
    return v;
}

#define XB_TMO      128
#define XB_XCNT(j)  (256  + 64 * (j))
#define XB_XSUB(j)  (1280 + 64 * (j))
#define XB_XGEN(j)  (2304 + 64 * (j))
#define XB_TOP      3328
#define XB_TOPGEN   3392
#define XCD_BAR_WORDS 3456
#define XB_SPIN_CAP (1u << 18)
__device__ __forceinline__ unsigned xb_ld(unsigned* p)              { return __hip_atomic_load(p, __ATOMIC_RELAXED, __HIP_MEMORY_SCOPE_AGENT); }
__device__ __forceinline__ unsigned xb_add(unsigned* p, unsigned v) { return __hip_atomic_fetch_add(p, v, __ATOMIC_RELAXED, __HIP_MEMORY_SCOPE_AGENT); }
__device__ __forceinline__ unsigned xb_xcc_id() { return (unsigned)__builtin_amdgcn_s_getreg((3 << 11) | 20) & 0xFu; }
#define XB_SPIN(cond, bar) do { unsigned _sp = 0; while (cond) { __builtin_amdgcn_s_sleep(1); \
    if ((++_sp & 255u) == 0u) { if (xb_ld(&(bar)[XB_TMO])) break; if (_sp > XB_SPIN_CAP) { atomicAdd(&(bar)[XB_TMO], 1u); break; } } } } while (0)
struct XcdBarrier { unsigned* bar; unsigned x; volatile LAS unsigned* st; };
__device__ __forceinline__ XcdBarrier xcd_barrier_post(unsigned* bar, volatile LAS unsigned* st) {
    XcdBarrier b; b.bar = bar; b.x = xb_xcc_id(); b.st = st;
    if (threadIdx.x == 0) (void)xb_add(&bar[XB_XCNT(b.x)], 1u);
    return b;
}
__device__ __forceinline__ void xcd_barrier_complete(unsigned* bar, unsigned x, unsigned& nloc, unsigned& nx) {
    const unsigned G = gridDim.x * gridDim.y * gridDim.z;
    unsigned sum, cnt, mine, sp = 0u;
    for (;;) {
        sum = 0u; cnt = 0u; mine = 0u;
#pragma unroll
        for (unsigned j = 0; j < 16; ++j) { const unsigned c = xb_ld(&bar[XB_XCNT(j)]); sum += c; cnt += (c > 0u) ? 1u : 0u; mine = (j == x) ? c : mine; }
        if (sum == G) break;
        __builtin_amdgcn_s_sleep(1);
        if ((++sp & 255u) == 0u) { if (xb_ld(&bar[XB_TMO])) break; if (sp > XB_SPIN_CAP) { atomicAdd(&bar[XB_TMO], 1u); break; } }
    }
    nloc = mine > 0u ? mine : 1u; nx = cnt > 0u ? cnt : 1u;
}
__device__ __forceinline__ void xcd_barrier(const XcdBarrier& b) {
    asm volatile("s_waitcnt vmcnt(0)" ::: "memory");
    __syncthreads();
    if (threadIdx.x == 0) {
        unsigned* bar = b.bar;
        __builtin_amdgcn_s_waitcnt(0);
        unsigned nloc = b.st[0], nx = b.st[1];
        if (nloc == 0u) { xcd_barrier_complete(bar, b.x, nloc, nx); b.st[0] = nloc; b.st[1] = nx; }
        const unsigned old = xb_add(&bar[XB_XSUB(b.x)], 1u);
        const unsigned gen = old / nloc;
        if (old + 1u == (gen + 1u) * nloc) {
            __builtin_amdgcn_fence(__ATOMIC_RELEASE, "agent");
            asm volatile("s_waitcnt vmcnt(0)" ::: "memory");
            const unsigned og = xb_add(&bar[XB_TOP], 1u);
            const unsigned tg = og / nx;
            if (og + 1u == (tg + 1u) * nx) xb_add(&bar[XB_TOPGEN], 1u);
            else XB_SPIN(xb_ld(&bar[XB_TOPGEN]) == tg, bar);
            __builtin_amdgcn_fence(__ATOMIC_ACQUIRE, "agent");
            xb_add(&bar[XB_XGEN(b.x)], 1u);
            asm volatile("s_waitcnt vmcnt(0)" ::: "memory");
        } else {
            XB_SPIN(xb_ld(&bar[XB_XGEN(b.x)]) == gen, bar);
            __builtin_amdgcn_fence(__ATOMIC_ACQUIRE, "agent");
            asm volatile("s_waitcnt vmcnt(0)" ::: "memory");
        }
    }
    __syncthreads();
}

struct Args { const float* in[22]; float* out; unsigned char* ws; };
enum { I_X = 0, I_C, I_CTX, I_CCTX, I_WADA, I_BADA, I_WIN, I_KVNORM, I_WUKV, I_QNORM, I_KNORM, I_RPB, I_WBR, I_WOUT, I_LNAG, I_LNAB, I_WUP, I_CONVW, I_CONVB, I_WDOWN, I_LNFG, I_LNFB };
struct Frame { LAS unsigned char* lds; int tid, lane, wave, G, vcu; };
constexpr int PTAB_OFF = LDSCTL_OFF + 512;
__device__ __forceinline__ unsigned long long ptab_get(const Frame& F, int i) {
    volatile LAS unsigned* t = (volatile LAS unsigned*)(F.lds + PTAB_OFF) + 2 * i;
    const unsigned lo = __builtin_amdgcn_readfirstlane(t[0]), hi = __builtin_amdgcn_readfirstlane(t[1]);
    return ((unsigned long long)hi << 32) | lo;
}
__device__ __forceinline__ const float* in_ptr(const Frame& F, int i) { return (const float*)(const GAS float*)ptab_get(F, i); }
__device__ __forceinline__ float* out_ptr(const Frame& F) { return (float*)(GAS float*)ptab_get(F, 22); }
__device__ __forceinline__ unsigned char* ws_ptr(const Frame& F) { return (unsigned char*)(GAS unsigned char*)ptab_get(F, 23); }
__device__ __forceinline__ int opq_v(int x) { asm volatile("" : "+v"(x)); return x; }
__device__ __forceinline__ int opq_s(int x) { asm volatile("" : "+s"(x)); return x; }
__device__ __forceinline__ LAS unsigned char* opq_l(LAS unsigned char* p) { unsigned v = (unsigned)(__UINTPTR_TYPE__)p; asm volatile("" : "+s"(v)); return (LAS unsigned char*)(__UINTPTR_TYPE__)v; }
__device__ __forceinline__ Frame fresh(const Frame& F0) { Frame F; F.lds = opq_l(F0.lds); F.tid = opq_v(F0.tid); F.lane = F.tid & 63; F.wave = __builtin_amdgcn_readfirstlane(F.tid >> 6); F.G = opq_s(F0.G); F.vcu = opq_s(F0.vcu); return F; }

template <bool PAIR = false>
__device__ __forceinline__ void transpose_item(const float* W, int K, int N, bf16* WT, LAS float* scr, int item, int lane) {
    const int nblk = N / 32, kb = item / nblk, nb = item % nblk, k0 = 64 * kb, n0 = 32 * nb;
    int d0 = n0; if (PAIR) { const int h = N / 2, cc = n0 >= h ? n0 - h : n0; d0 = (cc >> 7) * 256 + (n0 >= h ? 128 : 0) + (cc & 127); }
    float t[32];
#pragma unroll
    for (int i = 0; i < 32; ++i) { const int kk = 2 * i + (lane >> 5); t[i] = __builtin_nontemporal_load(W + (size_t)(k0 + kk) * N + n0 + (lane & 31)); }
#pragma unroll
    for (int i = 0; i < 32; ++i) { const int kk = 2 * i + (lane >> 5); scr[kk * 33 + (lane & 31)] = t[i]; }
    LDS_WAIT(); asm volatile("" ::: "memory");
    const int c = lane & 7;
#pragma unroll
    for (int j = 0; j < 4; ++j) { const int n = (lane >> 3) + 8 * j; const LAS float* s = scr + (8 * c) * 33 + n;
        v4u o; o.x = pk2(s[0 * 33], s[1 * 33]); o.y = pk2(s[2 * 33], s[3 * 33]); o.z = pk2(s[4 * 33], s[5 * 33]); o.w = pk2(s[6 * 33], s[7 * 33]);
        *(v4u*)(WT + (size_t)(d0 + n) * K + k0 + 8 * c) = o; }
    LDS_WAIT(); asm volatile("" ::: "memory");
}
constexpr float W8_SCALE = 64.0f, WB_SCALE = 128.0f, ACC_SCALE = 16.0f, WKV_SCALE = 32.0f;
__device__ __forceinline__ unsigned pk4_fp8(float a, float b, float c, float d) { int w = 0; w = __builtin_amdgcn_cvt_pk_fp8_f32(a, b, w, false); w = __builtin_amdgcn_cvt_pk_fp8_f32(c, d, w, true); return (unsigned)w; }
template <bool REMAP = false>
__device__ __forceinline__ void transpose_item_fp8(const float* W, int K, int N, unsigned char* WT, LAS float* scr, int item, int lane, float wscale) {
    const int nblk = N / 32, kb = item / nblk, nb = item % nblk, k0 = 64 * kb, n0 = 32 * nb;
    int d0 = n0; if (REMAP) { const int g = (n0 >> 5) & 7; d0 = (n0 & ~255) + (((g & 1) << 2) + (g >> 1)) * 32; }
    float t[32];
#pragma unroll
    for (int i = 0; i < 32; ++i) { const int kk = 2 * i + (lane >> 5); t[i] = __builtin_nontemporal_load(W + (size_t)(k0 + kk) * N + n0 + (lane & 31)); }
#pragma unroll
    for (int i = 0; i < 32; ++i) { const int kk = 2 * i + (lane >> 5); scr[kk * 33 + (lane & 31)] = t[i] * wscale; }
    LDS_WAIT(); asm volatile("" ::: "memory");
    const int c = lane & 7;
#pragma unroll
    for (int j = 0; j < 4; ++j) { const int n = (lane >> 3) + 8 * j; const LAS float* s = scr + (8 * c) * 33 + n;
        v2u o; o.x = pk4_fp8(s[0 * 33], s[1 * 33], s[2 * 33], s[3 * 33]); o.y = pk4_fp8(s[4 * 33], s[5 * 33], s[6 * 33], s[7 * 33]);
        *(v2u*)(WT + (size_t)(d0 + n) * K + k0 + 8 * c) = o; }
    LDS_WAIT(); asm volatile("" ::: "memory");
}
__device__ __forceinline__ void convert_weights(const Frame& F0, int l) {
    const Frame F = fresh(F0);
    LAS float* scr = (LAS float*)(F.lds + F.wave * 16384);
    const int gw = F.vcu * NWAVES + F.wave, NGW = F.G * NWAVES;
    constexpr int I_IN = (D / 64) * (N_IN / 32), I_UKV = (KVR / 64) * (KVW / 32), I_BR = (D / 64) * (D / 32), I_OUT = I_BR, I_UP = (D / 64) * (DFF2 / 32), I_DN = (DFF / 64) * (D / 32);
    constexpr int NITEMS = I_IN + I_UKV + 3 * I_BR + I_OUT + I_UP + I_DN;
    unsigned char* ws = ws_ptr(F);
    const float* w_in = in_ptr(F, I_WIN); const float* w_ukv = in_ptr(F, I_WUKV); const float* w_br = in_ptr(F, I_WBR); const float* w_out = in_ptr(F, I_WOUT); const float* w_up = in_ptr(F, I_WUP); const float* w_dn = in_ptr(F, I_WDOWN);
    for (int it = gw; it < NITEMS; it += NGW) {
        int r = it;
        if (r < I_IN) { transpose_item_fp8<true>(w_in + (size_t)l * D * N_IN, D, N_IN, (unsigned char*)(ws + WS_WIN), scr, r, F.lane, W8_SCALE); continue; } r -= I_IN;
        if (r < I_UKV) { transpose_item_fp8(w_ukv + (size_t)l * KVR * KVW, KVR, KVW, (unsigned char*)(ws + WS_WUKV), scr, r, F.lane, WKV_SCALE); continue; } r -= I_UKV;
        if (r < 3 * I_BR) { const int i = r / I_BR; transpose_item_fp8(w_br + (size_t)(l * 3 + i) * D * D, D, D, (unsigned char*)(ws + WS_WBR) + (size_t)i * D * D, scr, r % I_BR, F.lane, WB_SCALE); continue; } r -= 3 * I_BR;
        if (r < I_OUT) { transpose_item_fp8(w_out + (size_t)l * D * D, D, D, (unsigned char*)(ws + WS_WOUT), scr, r, F.lane, WB_SCALE); continue; } r -= I_OUT;
        if (r < I_UP) { transpose_item<true>(w_up + (size_t)l * D * DFF2, D, DFF2, (bf16*)(ws + WS_WUP), scr, r, F.lane); continue; } r -= I_UP;
        transpose_item(w_dn + (size_t)l * DFF * D, DFF, D, (bf16*)(ws + WS_WDN), scr, r, F.lane);
    }
    { constexpr int per = 32 * D / 16, nz = (NP - N_IN) / 32 * per;
      for (int i = F.vcu * 512 + F.tid; i < nz; i += F.G * 512) { const int g = (N_IN % 256) / 32 + i / per, gp = ((g & 1) << 2) + (g >> 1);
          ((v4u*)(ws + WS_WIN + (size_t)((N_IN & ~255) + gp * 32) * D))[i % per] = (v4u){0u, 0u, 0u, 0u}; } }
}
__device__ __forceinline__ void adaln_partial(const Frame& F0) {
    const Frame F = fresh(F0);
    LAS float* sc = (LAS float*)F.lds;
    float* MPART = (float*)(ws_ptr(F) + WS_MPART);
    const float* cin = in_ptr(F, I_C); const float* cctx = in_ptr(F, I_CCTX); const float* wada = in_ptr(F, I_WADA);
    for (int item = F.vcu; item < 768; item += F.G) {
        const int l = item / 384, rem = item % 384, chunk = rem >> 4, s = rem & 15;
        __syncthreads();
        for (int idx = F.tid; idx < 9 * 128; idx += 512) { const int bi = idx >> 7, k = idx & 127; const float v = bi < 8 ? cin[bi * D + s * 128 + k] : cctx[s * 128 + k]; sc[idx] = v / (1.0f + expf(-v)); }
        __syncthreads();
        const int j = chunk * 512 + F.tid;
        const float* W = wada + ((size_t)l * D + s * 128) * ADA + j;
        float acc[9];
#pragma unroll
        for (int bi = 0; bi < 9; ++bi) acc[bi] = 0.f;
        for (int k = 0; k < 128; k += 32) {
            float w[32];
#pragma unroll
            for (int kk = 0; kk < 32; ++kk) w[kk] = __builtin_nontemporal_load(W + (size_t)(k + kk) * ADA);
#pragma unroll
            for (int kk = 0; kk < 32; ++kk)
#pragma unroll
                for (int bi = 0; bi < 9; ++bi) acc[bi] = fmaf(sc[bi * 128 + k + kk], w[kk], acc[bi]);
        }
#pragma unroll
        for (int bi = 0; bi < 9; ++bi) MPART[((size_t)(l * 16 + s) * 9 + bi) * ADA + j] = acc[bi];
    }
    __syncthreads();
}
__device__ __forceinline__ void adaln_final(const Frame& F0) {
    const Frame F = fresh(F0);
    unsigned char* ws = ws_ptr(F); const float* bada = in_ptr(F, I_BADA);
    const float* MPART = (const float*)(ws + WS_MPART); float* MFIN = (float*)(ws + WS_MFIN);
    for (int idx = F.vcu * 512 + F.tid; idx < DEPTH * 9 * ADA; idx += F.G * 512) {
        const int l = idx / (9 * ADA), rem = idx % (9 * ADA), bi = rem / ADA, j = rem % ADA;
        float s = bada[l * ADA + j];
#pragma unroll
        for (int k = 0; k < 16; ++k) s += MPART[((size_t)(l * 16 + k) * 9 + bi) * ADA + j];
        MFIN[idx] = s;
    }
}

__device__ __forceinline__ void ln_inplace(f32x4 (&v)[8], float eps) {
    float s = 0.f;
#pragma unroll
    for (int j = 0; j < 8; ++j) s += (v[j].x + v[j].y) + (v[j].z + v[j].w);
    const float mean = wave_sum(s) * (1.f / D); float s2 = 0.f;
#pragma unroll
    for (int j = 0; j < 8; ++j) { v[j] = v[j] - mean; s2 += (v[j].x * v[j].x + v[j].y * v[j].y) + (v[j].z * v[j].z + v[j].w * v[j].w); }
    const float rstd = 1.f / sqrtf(wave_sum(s2) * (1.f / D) + eps);
#pragma unroll
    for (int j = 0; j < 8; ++j) v[j] = v[j] * rstd;
}
template <int KIND>
__device__ __forceinline__ void row_phase(const Frame& F0, int l, bool poison) {
    const Frame F = fresh(F0);
    unsigned char* ws = ws_ptr(F); float* outp = out_ptr(F); const float* xin = in_ptr(F, I_X); const float* ctxin = in_ptr(F, I_CTX);
    const float* lng = in_ptr(F, KIND == 1 ? I_LNAG : I_LNFG) + (size_t)l * D; const float* lnb = in_ptr(F, KIND == 1 ? I_LNAB : I_LNFB) + (size_t)l * D;
    const float* MFIN = (const float*)(ws + WS_MFIN);
    const bool last = (l == DEPTH - 1);
    const bool want_h = !(KIND == 2 && last);
    const int lm = (KIND == 2) ? l + 1 : l;
    LAS f32x4* LG = (LAS f32x4*)F.lds; LAS f32x4* LB = LG + 512; LAS f32x4* SETS = LG + 1024;
    const bool from_input = (KIND == 0) || (KIND == 1 && l == 0);
    for (int chunk = F.vcu; chunk < M / 72; chunk += F.G) {
        const int row_a = chunk * 72, row_b = row_a + 71;
        const int bA = row_a / TPB, bB = row_b / TPB; const int biA = (row_a - bA * TPB >= SEQ) ? 8 : bA, biB = (row_b - bB * TPB >= SEQ) ? 8 : bB;
        __syncthreads();
        { const int t = F.tid;
          if (KIND != 0) { LG[t] = ((const f32x4*)lng)[t]; LB[t] = ((const f32x4*)lnb)[t]; }
#pragma unroll
          for (int s_ = 0; s_ < 2; ++s_) { const int bi = s_ ? biB : biA;
              if (KIND != 0) SETS[s_ * 1536 + t] = ((const f32x4*)(MFIN + ((size_t)(l * 9 + bi) * 6 + (KIND == 1 ? 2 : 5)) * D))[t];
              if (want_h) { const float* sh = MFIN + ((size_t)(lm * 9 + bi) * 6 + (KIND == 1 ? 3 : 0)) * D; SETS[s_ * 1536 + 512 + t] = ((const f32x4*)sh)[t]; SETS[s_ * 1536 + 1024 + t] = ((const f32x4*)(sh + D))[t]; } } }
        __syncthreads();
        const int r0 = row_a + F.wave * 9;
        f32x4 xa[8], xb[8]; v2u ya[8], yb[8];
#define ROW_INFO(r, b_, i_, isctx_, skip_) const int b_ = (r) / TPB, i_ = (r) - b_ * TPB; const bool isctx_ = i_ >= SEQ; const bool skip_ = (KIND != 0 && last && isctx_)
#define ROW_XPTRS(b_, i_, isctx_, xsrc_, xdst_) float* xdst_ = isctx_ ? (float*)(ws + WS_XCTX) + (size_t)(b_ * CTXL + i_ - SEQ) * D : outp + (size_t)(b_ * SEQ + i_) * D; \
        const float* xsrc_ = from_input ? (isctx_ ? ctxin + (size_t)(b_ * CTXL + i_ - SEQ) * D : xin + (size_t)(b_ * SEQ + i_) * D) : xdst_
#define ROW_LOAD(r, X, Y) do { ROW_INFO(r, b_, i_, c_, sk_); if (!sk_) { ROW_XPTRS(b_, i_, c_, xs_, xd_); (void)xd_; \
        _Pragma("unroll") for (int j = 0; j < 8; ++j) X[j] = __builtin_nontemporal_load((const f32x4*)xs_ + F.lane + 64 * j); \
        if (KIND != 0) { const bf16* y_ = (const bf16*)(ws + (KIND == 1 ? WS_YOUT : WS_FOUT)) + (size_t)(r) * D; _Pragma("unroll") for (int j = 0; j < 8; ++j) Y[j] = __builtin_nontemporal_load((const v2u*)y_ + F.lane + 64 * j); } } } while (0)
#define ROW_PROC(r, X, Y) do { ROW_INFO(r, b_, i_, c_, sk_); if (!sk_) { ROW_XPTRS(b_, i_, c_, xs_, xd_); (void)xs_; const int bi_ = c_ ? 8 : b_; LAS f32x4* ST = SETS + (bi_ == biA ? 0 : 1536); \
        if (KIND != 0) { \
            _Pragma("unroll") for (int j = 0; j < 8; ++j) { const f32x4 yy = (f32x4){pg8::bf_lo(Y[j].x), pg8::bf_hi(Y[j].x), pg8::bf_lo(Y[j].y), pg8::bf_hi(Y[j].y)}; X[j] = X[j] * ALPHA + ST[F.lane + 64 * j] * yy; } \
            ln_inplace(X, POST_EPS); \
            _Pragma("unroll") for (int j = 0; j < 8; ++j) X[j] = X[j] * LG[F.lane + 64 * j] + LB[F.lane + 64 * j]; \
            if (poison) { _Pragma("unroll") for (int j = 0; j < 8; ++j) X[j] = X[j] * __builtin_nanf(""); } \
            _Pragma("unroll") for (int j = 0; j < 8; ++j) __builtin_nontemporal_store(X[j], (f32x4*)xd_ + F.lane + 64 * j); } \
        if (want_h) { ln_inplace(X, ADA_EPS); \
            bf16* h_ = (KIND == 1) ? (bf16*)(ws + WS_H2) + (size_t)(r) * D : (bf16*)(ws + WS_P) + (size_t)(r) * LDP + C_YA; \
            _Pragma("unroll") for (int j = 0; j < 8; ++j) { const f32x4 o_ = X[j] * (ST[1024 + F.lane + 64 * j] + 1.0f) + ST[512 + F.lane + 64 * j]; \
                if (KIND == 1) { v2u w_; w_.x = pk2(o_.x, o_.y); w_.y = pk2(o_.z, o_.w); ((v2u*)h_)[F.lane + 64 * j] = w_; } \
                else ((unsigned*)h_)[F.lane + 64 * j] = pk4_fp8(o_.x, o_.y, o_.z, o_.w); } } } } while (0)
        ROW_LOAD(r0, xa, ya);
#pragma unroll 1
        for (int k = 0; k < 8; k += 2) {
            ROW_LOAD(r0 + k + 1, xb, yb);
            ROW_PROC(r0 + k, xa, ya);
            ROW_LOAD(r0 + k + 2, xa, ya);
            ROW_PROC(r0 + k + 1, xb, yb);
        }
        ROW_PROC(r0 + 8, xa, ya);
#undef ROW_INFO
#undef ROW_XPTRS
#undef ROW_LOAD
#undef ROW_PROC
    }
    __syncthreads();
}

__device__ __forceinline__ void unpack8(const v4u x, float (&f)[8]) { f[0] = pg8::bf_lo(x.x); f[1] = pg8::bf_hi(x.x); f[2] = pg8::bf_lo(x.y); f[3] = pg8::bf_hi(x.y); f[4] = pg8::bf_lo(x.z); f[5] = pg8::bf_hi(x.z); f[6] = pg8::bf_lo(x.w); f[7] = pg8::bf_hi(x.w); }
__device__ __forceinline__ v4u pack8(const float (&f)[8]) { v4u o; o.x = pk2(f[0], f[1]); o.y = pk2(f[2], f[3]); o.z = pk2(f[4], f[5]); o.w = pk2(f[6], f[7]); return o; }
__device__ __forceinline__ void prep_phase(const Frame& F0, int l) {
    const Frame F = fresh(F0);
    const int gw = F.vcu * NWAVES + F.wave, NGW = F.G * NWAVES, lane = F.lane;
    unsigned char* ws = ws_ptr(F);
    bf16* P = (bf16*)(ws + WS_P); bf16* CB = (bf16*)(ws + WS_C); bf16* KRR = (bf16*)(ws + WS_KRR); unsigned char* KG8 = ws + WS_KG8;
    const float* kvn = in_ptr(F, I_KVNORM) + (size_t)l * KVR; const float* qn = in_ptr(F, I_QNORM) + (size_t)l * 128; const float* kn = in_ptr(F, I_KNORM) + (size_t)l * 128;
    const bool last = (l == DEPTH - 1);
    LAS float* TMc = (LAS float*)F.lds; LAS float* TMs = TMc + 65 * 16; LAS float* TGc = TMs + 65 * 16; LAS float* TGs = TGc + 65 * 32;
    __syncthreads();
    for (int idx = F.tid; idx < 65 * 16; idx += 512) { const int pos = idx >> 4, i = idx & 15; float sn = 0.f, cs = 1.f; if (pos < 64) sincosf((float)pos * exp2f(-(float)i * (13.287712379549449f / 16.0f)), &sn, &cs); TMc[idx] = cs; TMs[idx] = sn; }
    for (int idx = F.tid; idx < 65 * 32; idx += 512) { const int pos = idx >> 5, i = idx & 31; float sn = 0.f, cs = 1.f; if (pos < 64) sincosf((float)pos * exp2f(-(float)i * (13.287712379549449f / 32.0f)), &sn, &cs); TGc[idx] = cs; TGs[idx] = sn; }
    __syncthreads();
    const int l8 = lane & 7, l16 = lane & 15;
    float g8[8], qg[8], kg[8];
#pragma unroll
    for (int e = 0; e < 8; ++e) { g8[e] = kvn[lane * 8 + e]; qg[e] = qn[l16 * 8 + e]; kg[e] = kn[l16 * 8 + e]; }
    const bool m_col = (l8 >> 2) & 1, m_second = (l8 >> 1) & 1; const int m_i0 = 8 * (l8 & 1);
    const bool g_col = (l16 >> 3) & 1, g_second = (l16 >> 2) & 1; const int g_i0 = 8 * (l16 & 3);
    for (int r = gw; r < M; r += NGW) {
        const int b = r / TPB, i = r - b * TPB; const bool isctx = i >= SEQ;
        bf16* prow = P + (size_t)r * LDP;
        const int posr = isctx ? 64 : (i >> 6), posc = isctx ? 64 : (i & 63);
        { float f[8]; unpack8(*(const v4u*)(prow + C_CKV + lane * 8), f);
          float ss = 0.f;
#pragma unroll
          for (int e = 0; e < 8; ++e) ss += f[e] * f[e];
          const float rr = 1.f / sqrtf(wave_sum(ss) * (1.f / KVR) + RMS_EPS);
#pragma unroll
          for (int e = 0; e < 8; ++e) f[e] = f[e] * rr * g8[e];
          v2u w; w.x = pk4_fp8(f[0], f[1], f[2], f[3]); w.y = pk4_fp8(f[4], f[5], f[6], f[7]); *(v2u*)((unsigned char*)CB + (size_t)r * KVR + lane * 8) = w; }
        float mc[8], ms[8];
        { const int tb = (m_col ? posc : posr) * 16 + m_i0;
          const f32x4 c0 = *(const LAS f32x4*)(TMc + tb), c1 = *(const LAS f32x4*)(TMc + tb + 4), s0 = *(const LAS f32x4*)(TMs + tb), s1 = *(const LAS f32x4*)(TMs + tb + 4);
          mc[0] = c0.x; mc[1] = c0.y; mc[2] = c0.z; mc[3] = c0.w; mc[4] = c1.x; mc[5] = c1.y; mc[6] = c1.z; mc[7] = c1.w;
          ms[0] = s0.x; ms[1] = s0.y; ms[2] = s0.z; ms[3] = s0.w; ms[4] = s1.x; ms[5] = s1.y; ms[6] = s1.z; ms[7] = s1.w; }
#pragma unroll
        for (int p = 0; p < 3; ++p) {
            const bool act = (p == 0) ? (lane < 8) : !isctx;
            const bf16* src = (p == 0) ? prow + C_KR + l8 * 8 : prow + C_MQ + ((p - 1) * 8 + (lane >> 3)) * 192 + 128 + l8 * 8;
            bf16* dst = (p == 0) ? KRR + (size_t)r * 64 + l8 * 8 : (bf16*)src;
            float f[8], o[8]; v4u x = (v4u){0u, 0u, 0u, 0u}; if (act) x = *(const v4u*)src; unpack8(x, f);
#pragma unroll
            for (int e = 0; e < 8; ++e) { const float xp = __shfl_xor(f[e], 2); o[e] = m_second ? (xp * ms[e] + f[e] * mc[e]) : (f[e] * mc[e] - xp * ms[e]); }
            if (act) { if (p == 0) { v2u w; w.x = pk4_fp8(o[0], o[1], o[2], o[3]); w.y = pk4_fp8(o[4], o[5], o[6], o[7]); *(v2u*)((unsigned char*)KRR + (size_t)r * 64 + l8 * 8) = w; } else *(v4u*)dst = pack8(o); }
        }
        float gc[8], gs[8];
        { const int tb = (g_col ? posc : posr) * 32 + g_i0;
          const f32x4 c0 = *(const LAS f32x4*)(TGc + tb), c1 = *(const LAS f32x4*)(TGc + tb + 4), s0 = *(const LAS f32x4*)(TGs + tb), s1 = *(const LAS f32x4*)(TGs + tb + 4);
          gc[0] = c0.x; gc[1] = c0.y; gc[2] = c0.z; gc[3] = c0.w; gc[4] = c1.x; gc[5] = c1.y; gc[6] = c1.z; gc[7] = c1.w;
          gs[0] = s0.x; gs[1] = s0.y; gs[2] = s0.z; gs[3] = s0.w; gs[4] = s1.x; gs[5] = s1.y; gs[6] = s1.z; gs[7] = s1.w; }
        const int p0 = (last && isctx) ? 4 : 0;
        for (int p = p0; p < 5; ++p) {
            const bool isk = (p == 4);
            bf16* q = prow + (isk ? C_GK : C_GQ + p * 512) + (lane >> 4) * 128 + l16 * 8;
            float f[8], o[8]; unpack8(*(const v4u*)q, f);
            float ss = 0.f;
#pragma unroll
            for (int e = 0; e < 8; ++e) ss += f[e] * f[e];
            ss += __shfl_xor(ss, 1); ss += __shfl_xor(ss, 2); ss += __shfl_xor(ss, 4); ss += __shfl_xor(ss, 8);
            const float rr = 1.f / sqrtf(ss * (1.f / 128.f) + RMS_EPS);
#pragma unroll
            for (int e = 0; e < 8; ++e) f[e] = f[e] * rr * (isk ? kg[e] : qg[e]);
#pragma unroll
            for (int e = 0; e < 8; ++e) { const float xp = __shfl_xor(f[e], 4); o[e] = g_second ? (xp * gs[e] + f[e] * gc[e]) : (f[e] * gc[e] - xp * gs[e]); }
            if (isk) { v2u w; w.x = pk4_fp8(o[0], o[1], o[2], o[3]); w.y = pk4_fp8(o[4], o[5], o[6], o[7]); *(v2u*)(KG8 + (size_t)r * 512 + (lane >> 4) * 128 + l16 * 8) = w; }
            else { v2u w; w.x = pk4_fp8(o[0], o[1], o[2], o[3]); w.y = pk4_fp8(o[4], o[5], o[6], o[7]); *(v2u*)((unsigned char*)(q - l16 * 8) + l16 * 8) = w; }
        }
    }
    __syncthreads();
}

__device__ __forceinline__ void conv_fixup(const Frame& F0, int l) {
    const Frame F = fresh(F0);
    unsigned char* ws = ws_ptr(F);
    const bf16* SBG = (const bf16*)(ws + WS_SBG); const bf16* SBV = (const bf16*)(ws + WS_SBV); bf16* A = (bf16*)(ws + WS_A);
    const float* cw = in_ptr(F, I_CONVW) + (size_t)l * 3 * DFF; const float* cb = in_ptr(F, I_CONVB) + (size_t)l * DFF;
    const bool last = (l == DEPTH - 1);
    constexpr int CH = DFF / 8, NBLK = M / 64;
    const int total = NBLK * 2 * CH;
    const v4u Z = (v4u){0u, 0u, 0u, 0u};
    for (int idx = F.vcu * 512 + F.tid; idx < total; idx += F.G * 512) {
        const int ch = idx % CH, bs = idx / CH, s_ = bs & 1, B = bs >> 1, col = ch * 8;
        const int r = B * 64 + (s_ ? 63 : 0), b = r / TPB, i = r - b * TPB;
        if (last && i >= SEQ) continue;
        const bool hasl = (i != 0) && (i != SEQ), hasr = (i != SEQ - 1) && (i != TPB - 1);
        v4u gl, gc, gr, vv;
        if (s_ == 0) { gc = *(const v4u*)(SBG + ((size_t)B * 4 + 0) * DFF + col); gr = *(const v4u*)(SBG + ((size_t)B * 4 + 1) * DFF + col); gl = hasl ? *(const v4u*)(SBG + ((size_t)(B - 1) * 4 + 3) * DFF + col) : Z; vv = *(const v4u*)(SBV + ((size_t)B * 2 + 0) * DFF + col); }
        else { gc = *(const v4u*)(SBG + ((size_t)B * 4 + 3) * DFF + col); gl = *(const v4u*)(SBG + ((size_t)B * 4 + 2) * DFF + col); gr = hasr ? *(const v4u*)(SBG + ((size_t)(B + 1) * 4 + 0) * DFF + col) : Z; vv = *(const v4u*)(SBV + ((size_t)B * 2 + 1) * DFF + col); }
        float fl[8], fc[8], fr[8], fv[8], o[8]; unpack8(gl, fl); unpack8(gc, fc); unpack8(gr, fr); unpack8(vv, fv);
        const f32x4 w0a = *(const f32x4*)(cw + col), w0b = *(const f32x4*)(cw + col + 4), w1a = *(const f32x4*)(cw + DFF + col), w1b = *(const f32x4*)(cw + DFF + col + 4);
        const f32x4 w2a = *(const f32x4*)(cw + 2 * DFF + col), w2b = *(const f32x4*)(cw + 2 * DFF + col + 4), ba = *(const f32x4*)(cb + col), bb = *(const f32x4*)(cb + col + 4);
        const float w0[8] = {w0a.x, w0a.y, w0a.z, w0a.w, w0b.x, w0b.y, w0b.z, w0b.w}, w1[8] = {w1a.x, w1a.y, w1a.z, w1a.w, w1b.x, w1b.y, w1b.z, w1b.w};
        const float w2[8] = {w2a.x, w2a.y, w2a.z, w2a.w, w2b.x, w2b.y, w2b.z, w2b.w}, bs8[8] = {ba.x, ba.y, ba.z, ba.w, bb.x, bb.y, bb.z, bb.w};
#pragma unroll
        for (int e = 0; e < 8; ++e) { const float g = fl[e] * w0[e] + fc[e] * w1[e] + fr[e] * w2[e] + bs8[e]; o[e] = g * __builtin_amdgcn_rcpf(1.0f + __expf(-g)) * fv[e]; }
        *(v4u*)(A + (size_t)r * DFF + col) = pack8(o);
    }
}
__device__ __forceinline__ void attn_phase(const Frame& F0, int l) {
    const Frame F = fresh(F0);
    unsigned char* ws0 = ws_ptr(F); const float* rpb_in = in_ptr(F, I_RPB);
    bf16* P = (bf16*)(ws0 + WS_P); const unsigned char* KM8 = ws0 + WS_KM8; const unsigned char* VM8 = ws0 + WS_VM8; const unsigned char* VN8 = ws0 + WS_VN8; const unsigned char* VG8 = ws0 + WS_VG8; const unsigned char* KRR8 = ws0 + WS_KRR; const unsigned char* KG8 = ws0 + WS_KG8; const unsigned char* KN8 = ws0 + WS_KN8;
    const bool with_ctx = (l < DEPTH - 1);
    LAS char* lds = (LAS char*)F.lds;
    { const int nu = 1024 + (with_ctx ? 128 : 0);
      auto mk = [&](int u) -> att::AttnUnit {
        att::AttnUnit U; int b, h, row0;
        if (u < 1024) { b = u >> 7; h = (u >> 3) & 15; row0 = b * TPB + (u & 7) * 256; U.NT = 36; U.n0 = 36; U.base0 = b * TPB; U.base1 = 0; }
        else { const int v = u - 1024; b = v >> 4; h = v & 15; row0 = b * TPB + SEQ; U.NT = 4; U.n0 = 4; U.base0 = b * TPB + SEQ; U.base1 = 0; }
        U.Q = P + (size_t)row0 * LDP + C_MQ + h * 192; U.ldq = LDP;
        U.Kn = nullptr; U.ldkv = 2048; U.Kr = nullptr; U.ldkr = 0; U.V = nullptr; U.K8 = KM8 + h * 128; U.ldk8 = 2048; U.Kr8 = KRR8; U.V8 = VM8 + h * 128; U.ldv8 = 2048;
        U.O = P + (size_t)row0 * LDP + C_YA + h * 128; U.ldo = LDP; U.rpb = nullptr; U.qrow0 = 0; U.krow0 = 0;
        return U; };
      bool pre = false;
      for (int u = F.vcu; u < nu; u += F.G) { const bool hn = (u + F.G) < nu; const att::AttnUnit U = mk(u), N = mk(hn ? u + F.G : u);
        att::attn_body<192, 0, 1>(U, lds, N, hn, pre); pre = hn; }
      }
    { const int nu = 1024 + (with_ctx ? 256 : 0);
      auto mk = [&](int u) -> att::AttnUnit {
        att::AttnUnit U; int b, h, row0; int cq, cv; bool gqa = true;
        if (u < 1024) { b = u >> 7; h = (u >> 3) & 15; row0 = b * TPB + (u & 7) * 256; U.NT = 36; U.n0 = 36; U.base0 = b * TPB; }
        else { const int v = (u - 1024) & 127; b = v >> 4; h = v & 15; row0 = b * TPB + SEQ; U.NT = 4; U.n0 = 4; U.base0 = b * TPB + SEQ; gqa = (u < 1152); }
        if (gqa) { cq = C_GQ + h * 128; cv = C_GV + (h >> 2) * 128; U.K8 = KG8 + (h >> 2) * 128; U.ldk8 = 512; U.V8 = VG8 + (h >> 2) * 128; U.ldv8 = 512; } else { cq = C_NQ + h * 128; cv = C_NV + h * 128; U.K8 = KN8 + h * 128; U.ldk8 = 2048; U.V8 = VN8 + h * 128; U.ldv8 = 2048; }
        U.base1 = 0;
        U.Q = P + (size_t)row0 * LDP + cq; U.ldq = LDP; U.Kn = nullptr; U.ldkv = LDP; U.Kr = nullptr; U.ldkr = 0; U.V = P + cv;
        U.O = P + (size_t)row0 * LDP + cq; U.ldo = LDP; U.rpb = nullptr; U.qrow0 = 0; U.krow0 = 0; U.Kr8 = nullptr;
        return U; };
      bool pre = false;
      for (int u = F.vcu; u < nu; u += F.G) { const bool hn = (u + F.G) < nu; const att::AttnUnit U = mk(u), N = mk(hn ? u + F.G : u);
        att::attn_body<128, 0, 1, 1>(U, lds, N, hn, pre); pre = hn; }
      }
    { auto mk = [&](int u) -> att::AttnUnit {
        att::AttnUnit U; const int b = u >> 7, h = (u >> 3) & 15, qb = u & 7, row0 = b * TPB + qb * 256;
        int lo = 4 * qb - 4; lo = lo < 0 ? 0 : (lo > 24 ? 24 : lo); if (qb == 6) lo = 20;
        const int nlat = (qb == 0 || qb == 7) ? 8 : 12;
        U.NT = 4 + nlat; U.n0 = 4; U.base0 = b * TPB + SEQ; U.base1 = b * TPB + lo * 64; U.qrow0 = 4 * qb; U.krow0 = lo;
        U.Q = P + (size_t)row0 * LDP + C_NQ + h * 128; U.ldq = LDP; U.Kn = nullptr; U.ldkv = LDP; U.Kr = nullptr; U.ldkr = 0; U.V = P + C_NV + h * 128; U.K8 = KN8 + h * 128; U.ldk8 = 2048; U.Kr8 = nullptr; U.V8 = VN8 + h * 128; U.ldv8 = 2048;
        U.O = P + (size_t)row0 * LDP + C_NQ + h * 128; U.ldo = LDP; U.rpb = rpb_in + (size_t)(l * 16 + h) * 15 * 31;
        return U; };
      bool pre = false;
      for (int u = F.vcu; u < 1024; u += F.G) { const bool hn = (u + F.G) < 1024; const att::AttnUnit U = mk(u), N = mk(hn ? u + F.G : u);
        att::attn_body<128, 1, 1, 1>(U, lds, N, hn, pre); pre = hn; }
      }
}

template <int L>
__device__ __forceinline__ void layer_body(const Frame& F0) {
    constexpr int l = L;
    volatile LAS unsigned* MISC = (volatile LAS unsigned*)(F0.lds + MISC_OFF);
#define GRID_BAR() do { const Frame Fb_ = fresh(F0); volatile LAS unsigned* M_ = (volatile LAS unsigned*)(Fb_.lds + MISC_OFF); XcdBarrier b_; b_.bar = (unsigned*)(ws_ptr(Fb_) + WS_CTL) + CW_BAR; b_.x = (unsigned)__builtin_amdgcn_readfirstlane(M_[10]); b_.st = M_ + 8; xcd_barrier(b_); } while (0)
    {
        constexpr bool last = (l == DEPTH - 1);
        { const Frame F = fresh(F0); unsigned char* ws = ws_ptr(F); const int bx = opq_s(blockIdx.x), Gs = F.G; pg8::Gemm g{(const bf16*)(ws + WS_P) + C_YA, (const bf16*)(ws + WS_WIN), LDP, D / 2, 128}; pg8::StaticOrder S; if (!last) S.init(M / 256, NP / 256, Gs, bx, 0, 1); else S.init(64, NP / 256, Gs, bx, 1, 1, 8);
          pg8::EpiWin E{(bf16*)(ws + WS_P), LDP, 1.0f / W8_SCALE, ws, (unsigned char*)(ws + WS_KN8), (unsigned char*)(ws + WS_VN8), (unsigned char*)(ws + WS_VG8), C_NK, C_NV, C_GQ, C_GV, C_GATE, C_NQ};
          pg8::gemm_phase<pg8::EpiWin, true, true, true>(F.lds, g, S, E); }
        GRID_BAR();
        prep_phase(F0, l);
        GRID_BAR();
        { const Frame F = fresh(F0); unsigned char* ws = ws_ptr(F); const int bx = opq_s(blockIdx.x), Gs = F.G; pg8::Gemm g{(const bf16*)(ws + WS_C), (const bf16*)(ws + WS_WUKV), KVR / 2, KVR / 2, 128}; pg8::StaticOrder S; S.init(M / 256, KVW / 256, Gs, bx, 0, 1);
          pg8::EpiKV E{(unsigned char*)(ws + WS_KM8), (unsigned char*)(ws + WS_VM8), 1.0f / WKV_SCALE};
          pg8::gemm_phase<pg8::EpiKV, true, true, true>(F.lds, g, S, E); }
        GRID_BAR();
        attn_phase(F0, l);
        GRID_BAR();
        { const Frame F = fresh(F0); unsigned char* ws = ws_ptr(F); const int bx = opq_s(blockIdx.x), Gs = F.G; pg8::Gemm g{(const bf16*)(ws + WS_P), (const bf16*)(ws + WS_WBR), LDP, D / 2, 256}; pg8::StaticOrder S; S.init(last ? 64 : 72, D / 256, Gs, bx, last ? 1 : 0, 3);
          pg8::EpiMerge E{(bf16*)(ws + WS_ACC), D, (const bf16*)(ws + WS_P) + C_GATE, LDP, C_YA, C_NQ, C_GQ, 1.0f / (WB_SCALE * att::YS), (unsigned char*)(ws + WS_ACC8), ACC_SCALE};
          pg8::gemm_phase<pg8::EpiMerge, true, true, true>(F.lds, g, S, E); }
        GRID_BAR();
        { const Frame F = fresh(F0); unsigned char* ws = ws_ptr(F); const int bx = opq_s(blockIdx.x), Gs = F.G; pg8::Gemm g{(const bf16*)(ws + WS_ACC8), (const bf16*)(ws + WS_WOUT), D / 2, D / 2, 128}; pg8::StaticOrder S; S.init(last ? 64 : 72, D / 256, Gs, bx, last ? 1 : 0, 1);
          pg8::EpiBf16 E{(bf16*)(ws + WS_YOUT), D, 1.0f / (WB_SCALE * ACC_SCALE)};
          pg8::gemm_phase<pg8::EpiBf16, true, true, true>(F.lds, g, S, E); }
        GRID_BAR();
        row_phase<1>(F0, l, false);
        GRID_BAR();
        { const Frame F = fresh(F0); unsigned char* ws = ws_ptr(F); const int bx = opq_s(blockIdx.x), Gs = F.G; pg8::Gemm g{(const bf16*)(ws + WS_H2), (const bf16*)(ws + WS_WUP), D, D, 128}; pg8::StaticOrder S; S.init(last ? 64 : 72, DFF2 / 256, Gs, bx, last ? 1 : 0, 1);
          pg8::EpiConv E{(bf16*)(ws + WS_A), DFF, in_ptr(F, I_CONVW) + (size_t)l * 3 * DFF, in_ptr(F, I_CONVB) + (size_t)l * DFF, (bf16*)(ws + WS_SBG), (bf16*)(ws + WS_SBV)};
          pg8::gemm_phase<pg8::EpiConv, true, true>(F.lds, g, S, E); }
        GRID_BAR();
        conv_fixup(F0, l);
        GRID_BAR();
        { const Frame F = fresh(F0); unsigned char* ws = ws_ptr(F); const int bx = opq_s(blockIdx.x), Gs = F.G; pg8::Gemm g{(const bf16*)(ws + WS_A), (const bf16*)(ws + WS_WDN), DFF, DFF, 128}; pg8::StaticOrder S; S.init(last ? 64 : 72, D / 256, Gs, bx, last ? 1 : 0, 1);
          pg8::EpiBf16 E{(bf16*)(ws + WS_FOUT), D, 1.0f};
          pg8::gemm_phase<pg8::EpiBf16, true, true>(F.lds, g, S, E); }
        GRID_BAR();
        { const Frame F = fresh(F0); const bool poison = last && (xb_ld((unsigned*)(ws_ptr(F) + WS_CTL) + CW_BAR + XB_TMO) != 0u);
          row_phase<2>(F0, l, poison); }
        if (!last) { convert_weights(F0, l + 1); GRID_BAR(); }
    }
}

__global__ void __launch_bounds__(NWAVES * 64, 2) fwd_kernel(Args a) {
    extern __shared__ __attribute__((aligned(16))) unsigned char lds_raw[];
    Frame F;
    F.lds = (LAS unsigned char*)lds_raw;
    F.tid = threadIdx.x; F.lane = F.tid & 63; F.wave = __builtin_amdgcn_readfirstlane(F.tid >> 6);
    F.G = gridDim.x; { const int bx = blockIdx.x; F.vcu = (F.G % 8 == 0) ? (bx % 8) * (F.G / 8) + bx / 8 : bx; }
    volatile LAS unsigned* MISC = (volatile LAS unsigned*)(F.lds + MISC_OFF);
    for (int u = F.tid; u < (LDS_BYTES - LDSCTL_OFF) / 4; u += NWAVES * 64) ((LAS unsigned*)(F.lds + LDSCTL_OFF))[u] = 0u;
    __syncthreads();
    if (F.tid == 0) { LAS unsigned long long* pt = (LAS unsigned long long*)(F.lds + PTAB_OFF);
#pragma unroll
        for (int i = 0; i < 22; ++i) pt[i] = (unsigned long long)a.in[i];
        pt[22] = (unsigned long long)a.out; pt[23] = (unsigned long long)a.ws; }
    __syncthreads();
    { XcdBarrier b0 = xcd_barrier_post((unsigned*)(ws_ptr(F) + WS_CTL) + CW_BAR, MISC + 8); if (F.tid == 0) MISC[10] = b0.x; }
    __syncthreads();

    { const Frame& F0 = F;
    adaln_partial(F);
    convert_weights(F, 0);
    GRID_BAR();
    adaln_final(F);
    GRID_BAR();
    row_phase<0>(F, 0, false);
    GRID_BAR(); }

    layer_body<0>(F);
    layer_body<1>(F);
}

extern "C" void kernel_launch(void* const* d_in, const int* in_sizes, int n_in, void* d_out, int out_size, void* d_ws, size_t ws_size, hipStream_t stream) {
    static int grid = 0;
    if (grid == 0) {
        if (n_in != 22 || out_size != NB * SEQ * D || ws_size < WS_END) { fprintf(stderr, "kernel_launch: shape/workspace mismatch (n_in %d out %d ws %zu need %zu)\n", n_in, out_size, ws_size, (size_t)WS_END); grid = -1; return; }
        int dev = 0, cus = 0, per_cu = 0;
        if (hipGetDevice(&dev) != hipSuccess || hipDeviceGetAttribute(&cus, hipDeviceAttributeMultiprocessorCount, dev) != hipSuccess) { grid = -1; return; }
        if (hipFuncSetAttribute((const void*)fwd_kernel, hipFuncAttributeMaxDynamicSharedMemorySize, LDS_BYTES) != hipSuccess) { grid = -1; return; }
        if (hipOccupancyMaxActiveBlocksPerMultiprocessor(&per_cu, (const void*)fwd_kernel, NWAVES * 64, LDS_BYTES) != hipSuccess || per_cu < 1) fprintf(stderr, "kernel_launch: occupancy query reports %d\n", per_cu);
        (void)hipGetLastError();
        grid = cus;
    }
    if (grid < 0) return;
    if (hipMemsetAsync((char*)d_ws + WS_CTL, 0, CTL_ZERO_BYTES, stream) != hipSuccess) return;
    Args a{};
    for (int i = 0; i < 22; ++i) a.in[i] = (const float*)d_in[i];
    a.out = (float*)d_out; a.ws = (unsigned char*)d_ws;
    hipLaunchKernelGGL(fwd_kernel, dim3(grid), dim3(NWAVES * 64), LDS_BYTES, stream, a);
    const hipError_t le = hipPeekAtLastError();
    if (le != hipSuccess) fprintf(stderr, "kernel_launch: launch failed: %s\n", hipGetErrorName(le));
}
```

```cpp
#include <hip/hip_runtime.h>
#include <cstdio>
#include <cstdint>
namespace pg8 {
#define PG8_LAS __attribute__((address_space(3)))
typedef unsigned short bf16_t;
typedef short bf16x8 __attribute__((ext_vector_type(8)));
typedef float f32x4 __attribute__((ext_vector_type(4)));
typedef unsigned u32x4 __attribute__((ext_vector_type(4)));
constexpr int BM = 256, BK = 64, HALF = 128, HTB = HALF * BK * 2, STAGE_BYTES = 8 * HTB, NXCD = 8, WGM = 8;

__host__ __device__ __forceinline__ int lds_byte(int r, int c) { const int st = (r >> 4) * 2 + (c >> 5), rr = r & 15, cc = c & 31, ob = rr * 64 + cc * 2; return st * 1024 + (ob ^ (((ob >> 9) & 1) << 5)); }
__host__ __device__ __forceinline__ void stage_rc(int b, int& R, int& C) { const int st = b / 1024, sb = b % 1024, swz = sb ^ (((sb >> 9) & 1) << 5); R = (st >> 1) * 16 + swz / 64; C = (st & 1) * 32 + (swz % 64) / 2; }
__host__ __device__ __forceinline__ int perm32(int rho) { const int n = rho >> 4, i = rho & 15; return 8 * (i >> 2) + 4 * n + (i & 3); }

struct Unit { int pm, pn, z; };
struct Gemm { const bf16_t* A; const bf16_t* Bt; int lda, K, kstepA; };

struct StaticOrder {
    int nM, nN, nwg, G, c, skip9, nz, nlat;
    __device__ void init(int nM_, int nN_, int G_, int c_, int skip9_, int nz_, int nctx25_ = 0) { nM = nM_; nN = nN_; nlat = nM * nN; nwg = nlat + nctx25_ * 25; G = G_; c = c_; skip9 = skip9_; nz = nz_; }
    __device__ bool next(int i, Unit& u) const {
        const int it = i / nz; u.z = i - it * nz;
        const long L = (long)it * G + c; if (L >= nwg) return false;
        int wgid = (int)L; { const int q = nwg / NXCD, r = nwg % NXCD, xcd = wgid % NXCD, off = wgid / NXCD; wgid = (xcd < r ? xcd * (q + 1) : r * (q + 1) + (xcd - r) * q) + off; }
        if (wgid >= nlat) { const int j_ = wgid - nlat, i_ = j_ / 25, jj = j_ - i_ * 25; u.pm = 9 * i_ + 8; u.pn = jj < 3 ? 12 + jj : (jj < 20 ? 19 + jj : 26 + jj); return true; }
        const int nig = WGM * nN, gid = wgid / nig, fm = gid * WGM, gsz = (nM - fm) < WGM ? (nM - fm) : WGM;
        int pm = fm + ((wgid % nig) % gsz); u.pn = (wgid % nig) / gsz;
        if (skip9) pm += pm >> 3;
        u.pm = pm; return true;
    }
};

__device__ __forceinline__ unsigned cvt_pk_bf16(float lo, float hi) { unsigned r; asm volatile("v_cvt_pk_bf16_f32 %0, %1, %2" : "=v"(r) : "v"(lo), "v"(hi)); return r; }

struct EpiF32 {
    static constexpr bool PERM = false; static constexpr int NST = 16;
    float* C; int ldc; float scale;
    __device__ __forceinline__ size_t aoff(const Unit& u, int lda) const { return (size_t)u.pm * BM * lda * 2; }
    __device__ __forceinline__ size_t boff(const Unit& u, int K) const { return (size_t)u.pn * BM * K * 2; }
    __device__ __forceinline__ void operator()(const f32x4 (&acc)[2][2][4][2], const Unit& u, int wr, int wc, int fr, int fq) const {
        const int row0 = u.pm * BM + wr * 64 + fr, col0 = u.pn * BM + wc * 32 + 4 * fq;
#pragma unroll
        for (int ai = 0; ai < 2; ++ai)
#pragma unroll
            for (int m = 0; m < 4; ++m) { float* rowp = C + (size_t)(row0 + ai * HALF + m * 16) * ldc + col0;
#pragma unroll
                for (int bj = 0; bj < 2; ++bj)
#pragma unroll
                    for (int n = 0; n < 2; ++n) *(f32x4*)(rowp + bj * HALF + n * 16) = acc[ai][bj][m][n] * scale; }
    }
};
struct EpiBf16 {
    static constexpr bool PERM = true; static constexpr int NST = 16;
    bf16_t* O; int ldc; float scale;
    __device__ __forceinline__ size_t aoff(const Unit& u, int lda) const { return (size_t)u.pm * BM * lda * 2; }
    __device__ __forceinline__ size_t boff(const Unit& u, int K) const { return (size_t)u.pn * BM * K * 2; }
    __device__ __forceinline__ void operator()(const f32x4 (&acc)[2][2][4][2], const Unit& u, int wr, int wc, int fr, int fq) const {
        const int row0 = u.pm * BM + wr * 64 + fr, col0 = u.pn * BM + wc * 32 + 8 * fq;
#pragma unroll
        for (int ai = 0; ai < 2; ++ai)
#pragma unroll
            for (int m = 0; m < 4; ++m) { bf16_t* rowp = O + (size_t)(row0 + ai * HALF + m * 16) * ldc + col0;
#pragma unroll
                for (int bj = 0; bj < 2; ++bj) { const f32x4 v0 = acc[ai][bj][m][0] * scale, v1 = acc[ai][bj][m][1] * scale;
                    u32x4 w; w.x = cvt_pk_bf16(v0[0], v0[1]); w.y = cvt_pk_bf16(v0[2], v0[3]); w.z = cvt_pk_bf16(v1[0], v1[1]); w.w = cvt_pk_bf16(v1[2], v1[3]);
                    *(u32x4*)(rowp + bj * HALF) = w; } }
    }
};
struct EpiKV {
    static constexpr bool PERM = true; static constexpr int NST = 16;
    unsigned char* K8; unsigned char* V8; float scale;
    __device__ __forceinline__ size_t aoff(const Unit& u, int lda) const { return (size_t)u.pm * BM * lda * 2; }
    __device__ __forceinline__ size_t boff(const Unit& u, int K) const { return (size_t)u.pn * BM * K * 2; }
    __device__ __forceinline__ void operator()(const f32x4 (&acc)[2][2][4][2], const Unit& u, int wr, int wc, int fr, int fq) const {
        const int row0 = u.pm * BM + wr * 64 + fr, col0 = u.pn * 128 + wc * 32 + 8 * fq;
        typedef unsigned u32x2 __attribute__((ext_vector_type(2)));
#pragma unroll
        for (int ai = 0; ai < 2; ++ai)
#pragma unroll
            for (int m = 0; m < 4; ++m) { const size_t row = (size_t)(row0 + ai * HALF + m * 16);
                { const f32x4 v0 = acc[ai][0][m][0] * scale, v1 = acc[ai][0][m][1] * scale; int w0 = 0, w1 = 0;
                  w0 = __builtin_amdgcn_cvt_pk_fp8_f32(v0[0], v0[1], w0, false); w0 = __builtin_amdgcn_cvt_pk_fp8_f32(v0[2], v0[3], w0, true);
                  w1 = __builtin_amdgcn_cvt_pk_fp8_f32(v1[0], v1[1], w1, false); w1 = __builtin_amdgcn_cvt_pk_fp8_f32(v1[2], v1[3], w1, true);
                  *(u32x2*)(K8 + row * 2048 + col0) = (u32x2){(unsigned)w0, (unsigned)w1}; }
                { const f32x4 v0 = acc[ai][1][m][0] * scale, v1 = acc[ai][1][m][1] * scale; int w0 = 0, w1 = 0;
                  w0 = __builtin_amdgcn_cvt_pk_fp8_f32(v0[0], v0[1], w0, false); w0 = __builtin_amdgcn_cvt_pk_fp8_f32(v0[2], v0[3], w0, true);
                  w1 = __builtin_amdgcn_cvt_pk_fp8_f32(v1[0], v1[1], w1, false); w1 = __builtin_amdgcn_cvt_pk_fp8_f32(v1[2], v1[3], w1, true);
                  *(u32x2*)(V8 + row * 2048 + col0) = (u32x2){(unsigned)w0, (unsigned)w1}; } }
    }
};
struct EpiWin {
    static constexpr bool PERM = true; static constexpr int NST = 8;
    bf16_t* O; int ldc; float scale; unsigned char* base8; unsigned char* KN8; unsigned char* VN8; unsigned char* VG8; int c_nk, c_nv, c_gq, c_gv, c_gate, c_nq;
    __device__ __forceinline__ size_t aoff(const Unit& u, int lda) const { return (size_t)u.pm * BM * lda * 2; }
    __device__ __forceinline__ size_t boff(const Unit& u, int K) const { return (size_t)u.pn * BM * K * 2; }
    __device__ __forceinline__ void operator()(const f32x4 (&acc)[2][2][4][2], const Unit& u, int wr, int wc, int fr, int fq) const {
        const int row0 = u.pm * BM + wr * 64 + fr, col = u.pn * BM + wc * 64 + 8 * fq;
        const bool in_nk = (col >= c_nk) && (col < c_nv), in_nv = (col >= c_nv) && (col < c_gq), in_gv = (col >= c_gv) && (col < c_gate), in_gt = (col >= c_gate) && (col < c_gate + 6144), in_nq = (col >= c_nq) && (col < c_nk), is8 = in_nk || in_nv || in_gv || in_gt || in_nq;
        const float sc = in_gt ? scale * -1.4426950408889634f : scale;
        if (is8) {
            const size_t a8 = (in_nk ? (size_t)(KN8 - base8) + (size_t)(col - c_nk) : 0) + (in_nv ? (size_t)(VN8 - base8) + (size_t)(col - c_nv) : 0) + (in_gv ? (size_t)(VG8 - base8) + (size_t)(col - c_gv) : 0) + (in_gt ? (size_t)((unsigned char*)O - base8) + (size_t)c_gate * 2 + (size_t)(col - c_gate) : 0)
                + (in_nq ? (size_t)((unsigned char*)O - base8) + (size_t)c_nq * 2 + (size_t)(((col - c_nq) >> 7) * 256 + ((col - c_nq) & 127)) : 0);
            const int ld8 = in_gv ? 512 : ((in_gt || in_nq) ? ldc * 2 : 2048);
            unsigned char* dl = base8 + a8 + ((fq & 1) ? 24 : 0);
#pragma unroll
            for (int ai = 0; ai < 2; ++ai)
#pragma unroll
                for (int m = 0; m < 4; ++m) { const size_t row = (size_t)(row0 + ai * HALF + m * 16);
                    unsigned b0[2], b1[2];
#pragma unroll
                    for (int bj = 0; bj < 2; ++bj) { const f32x4 v0 = acc[ai][bj][m][0] * sc, v1 = acc[ai][bj][m][1] * sc; int w0 = 0, w1 = 0;
                        w0 = __builtin_amdgcn_cvt_pk_fp8_f32(v0[0], v0[1], w0, false); w0 = __builtin_amdgcn_cvt_pk_fp8_f32(v0[2], v0[3], w0, true);
                        w1 = __builtin_amdgcn_cvt_pk_fp8_f32(v1[0], v1[1], w1, false); w1 = __builtin_amdgcn_cvt_pk_fp8_f32(v1[2], v1[3], w1, true);
                        if (bj == 0) { b0[0] = (unsigned)w0; b0[1] = (unsigned)w1; } else { b1[0] = (unsigned)w0; b1[1] = (unsigned)w1; } }
                    { auto r = __builtin_amdgcn_permlane16_swap(b0[0], b1[0], false, false); b0[0] = r[0]; b1[0] = r[1]; }
                    { auto r = __builtin_amdgcn_permlane16_swap(b0[1], b1[1], false, false); b0[1] = r[0]; b1[1] = r[1]; }
                    *(u32x4*)(dl + row * ld8) = (u32x4){b0[0], b0[1], b1[0], b1[1]}; }
        } else {
            const int hi8 = fr >> 3; bf16_t* ob = O + col + 32 * hi8;
#pragma unroll
            for (int ai = 0; ai < 2; ++ai)
#pragma unroll
                for (int m = 0; m < 4; ++m) { const size_t row = (size_t)(row0 + ai * HALF + m * 16);
                    unsigned b0[4], b1[4], n0[4], n1[4];
                    { const f32x4 v0 = acc[ai][0][m][0] * sc, v1 = acc[ai][0][m][1] * sc; b0[0] = cvt_pk_bf16(v0[0], v0[1]); b0[1] = cvt_pk_bf16(v0[2], v0[3]); b0[2] = cvt_pk_bf16(v1[0], v1[1]); b0[3] = cvt_pk_bf16(v1[2], v1[3]); }
                    { const f32x4 v0 = acc[ai][1][m][0] * sc, v1 = acc[ai][1][m][1] * sc; b1[0] = cvt_pk_bf16(v0[0], v0[1]); b1[1] = cvt_pk_bf16(v0[2], v0[3]); b1[2] = cvt_pk_bf16(v1[0], v1[1]); b1[3] = cvt_pk_bf16(v1[2], v1[3]); }
#pragma unroll
                    for (int d = 0; d < 4; ++d) {
                        n0[d] = (unsigned)__builtin_amdgcn_update_dpp((int)b0[d], (int)b1[d], 0x128, 0xf, 0xc, false);
                        n1[d] = (unsigned)__builtin_amdgcn_update_dpp((int)b1[d], (int)b0[d], 0x128, 0xf, 0x3, false); }
                    *(u32x4*)(ob + (row - 8 * hi8) * ldc) = (u32x4){n0[0], n0[1], n0[2], n0[3]};
                    *(u32x4*)(ob + (row + 8 - 8 * hi8) * ldc) = (u32x4){n1[0], n1[1], n1[2], n1[3]}; }
        }
    }
};
__device__ __forceinline__ float dpp_ror1(float x) { return __builtin_bit_cast(float, __builtin_amdgcn_update_dpp(0, __builtin_bit_cast(int, x), 0x121, 0xf, 0xf, false)); }
__device__ __forceinline__ float dpp_ror15(float x) { return __builtin_bit_cast(float, __builtin_amdgcn_update_dpp(0, __builtin_bit_cast(int, x), 0x12f, 0xf, 0xf, false)); }
struct EpiConv {
    static constexpr bool PERM = true; static constexpr int NST = 16;
    bf16_t* A; int dff; const float* cw; const float* cb; bf16_t* SBG; bf16_t* SBV;
    __device__ __forceinline__ size_t aoff(const Unit& u, int lda) const { return (size_t)u.pm * BM * lda * 2; }
    __device__ __forceinline__ size_t boff(const Unit& u, int K) const { return (size_t)u.pn * BM * K * 2; }
    __device__ __forceinline__ void operator()(const f32x4 (&acc)[2][2][4][2], const Unit& u, int wr, int wc, int fr, int fq) const {
        const int col = u.pn * 128 + wc * 32 + 8 * fq;
        float w0[8], w1[8], w2[8], bs[8];
        { const f32x4 a0 = *(const f32x4*)(cw + col), a1 = *(const f32x4*)(cw + col + 4), b0 = *(const f32x4*)(cw + dff + col), b1 = *(const f32x4*)(cw + dff + col + 4);
          const f32x4 c0 = *(const f32x4*)(cw + 2 * dff + col), c1 = *(const f32x4*)(cw + 2 * dff + col + 4), d0 = *(const f32x4*)(cb + col), d1 = *(const f32x4*)(cb + col + 4);
#pragma unroll
          for (int e = 0; e < 4; ++e) { w0[e] = a0[e]; w0[4 + e] = a1[e]; w1[e] = b0[e]; w1[4 + e] = b1[e]; w2[e] = c0[e]; w2[4 + e] = c1[e]; bs[e] = d0[e]; bs[4 + e] = d1[e]; } }
#pragma unroll
        for (int ai = 0; ai < 2; ++ai) {
            const int blk = u.pm * 4 + ai * 2 + wr; const size_t row0 = (size_t)u.pm * BM + ai * HALF + wr * 64 + fr;
#pragma unroll
            for (int m = 0; m < 4; ++m) {
                float o[8];
#pragma unroll
                for (int e = 0; e < 8; ++e) { const float gcur = acc[ai][0][m][e >> 2][e & 3];
                    const float pm1 = (m > 0) ? acc[ai][0][m > 0 ? m - 1 : 0][e >> 2][e & 3] : 0.f, pp1 = (m < 3) ? acc[ai][0][m < 3 ? m + 1 : 3][e >> 2][e & 3] : 0.f;
                    const float ra = dpp_ror1(gcur), rb = dpp_ror1(pm1), sa = dpp_ror15(gcur), sb = dpp_ror15(pp1);
                    const float gprev = (fr == 0) ? rb : ra, gnext = (fr == 15) ? sb : sa;
                    const float x = gprev * w0[e] + gcur * w1[e] + gnext * w2[e] + bs[e];
                    o[e] = x * __builtin_amdgcn_rcpf(1.0f + __expf(-x)) * acc[ai][1][m][e >> 2][e & 3]; }
                const bool boundary = (m == 0 && fr == 0) || (m == 3 && fr == 15);
                if (!boundary) { u32x4 w; w.x = cvt_pk_bf16(o[0], o[1]); w.y = cvt_pk_bf16(o[2], o[3]); w.z = cvt_pk_bf16(o[4], o[5]); w.w = cvt_pk_bf16(o[6], o[7]);
                    *(u32x4*)(A + (row0 + m * 16) * dff + col) = w; }
                if (m == 0 || m == 3) {
                    const bool sg = (m == 0) ? (fr < 2) : (fr >= 14); const int slot = (m == 0) ? fr : 2 + (fr - 14);
                    if (sg) { const f32x4 g0 = acc[ai][0][m][0], g1 = acc[ai][0][m][1]; u32x4 w; w.x = cvt_pk_bf16(g0[0], g0[1]); w.y = cvt_pk_bf16(g0[2], g0[3]); w.z = cvt_pk_bf16(g1[0], g1[1]); w.w = cvt_pk_bf16(g1[2], g1[3]);
                        *(u32x4*)(SBG + ((size_t)blk * 4 + slot) * dff + col) = w; }
                    const bool sv = (m == 0) ? (fr == 0) : (fr == 15);
                    if (sv) { const f32x4 v0 = acc[ai][1][m][0], v1 = acc[ai][1][m][1]; u32x4 w; w.x = cvt_pk_bf16(v0[0], v0[1]); w.y = cvt_pk_bf16(v0[2], v0[3]); w.z = cvt_pk_bf16(v1[0], v1[1]); w.w = cvt_pk_bf16(v1[2], v1[3]);
                        *(u32x4*)(SBV + ((size_t)blk * 2 + (m == 0 ? 0 : 1)) * dff + col) = w; } }
            }
        }
    }
};
__device__ __forceinline__ float bf_lo(unsigned w) { return __uint_as_float(w << 16); }
__device__ __forceinline__ float bf_hi(unsigned w) { return __uint_as_float(w & 0xffff0000u); }
__device__ __forceinline__ float sigmoidf_(float x) { return __builtin_amdgcn_rcpf(1.0f + __expf(-x)); }
struct EpiMerge {
    static constexpr bool PERM = true; static constexpr int NST = 16;
    bf16_t* ACC; int ldc; const bf16_t* G; int ldg; int acol0, acol1, acol2; float scale; unsigned char* ACC8; float oscale;
    __device__ __forceinline__ size_t aoff(const Unit& u, int lda) const { const int ac = (u.z == 0) ? acol0 : acol1 + (u.z - 1) * (acol2 - acol1); return (size_t)u.pm * BM * lda * 2 + (size_t)ac * 2; }
    __device__ __forceinline__ size_t boff(const Unit& u, int K) const { return (size_t)(u.z * 2048 + u.pn * BM) * K * 2; }
    __device__ __forceinline__ void operator()(const f32x4 (&acc)[2][2][4][2], const Unit& u, int wr, int wc, int fr, int fq) const {
        const int row0 = u.pm * BM + wr * 64 + fr, col0 = u.pn * BM + wc * 32 + 8 * fq;
        typedef unsigned u32x2 __attribute__((ext_vector_type(2)));
#pragma unroll
        for (int ai = 0; ai < 2; ++ai) {
            u32x2 gv[4][2]; u32x4 pv[4][2];
#pragma unroll
            for (int m = 0; m < 4; ++m) { const size_t row = (size_t)(row0 + ai * HALF + m * 16); const unsigned char* gp = (const unsigned char*)G + row * ldg * 2 + u.z * 2048 + col0; const bf16_t* rowp = ACC + row * ldc + col0;
#pragma unroll
                for (int bj = 0; bj < 2; ++bj) { gv[m][bj] = *(const u32x2*)(gp + bj * HALF); pv[m][bj] = (u32x4){0u, 0u, 0u, 0u}; if (u.z != 0) pv[m][bj] = *(const u32x4*)(rowp + bj * HALF); } }
#pragma unroll
            for (int m = 0; m < 4; ++m) { const size_t row = (size_t)(row0 + ai * HALF + m * 16); bf16_t* rowp = ACC + row * ldc + col0; unsigned char* r8 = ACC8 + row * 2048 + col0;
#pragma unroll
                for (int bj = 0; bj < 2; ++bj) { const f32x4 v0 = acc[ai][bj][m][0] * scale, v1 = acc[ai][bj][m][1] * scale; const u32x2 g = gv[m][bj]; const u32x4 p = pv[m][bj];
                    const auto g0 = __builtin_amdgcn_cvt_pk_f32_fp8((int)g.x, false), g1 = __builtin_amdgcn_cvt_pk_f32_fp8((int)g.x, true), g2 = __builtin_amdgcn_cvt_pk_f32_fp8((int)g.y, false), g3 = __builtin_amdgcn_cvt_pk_f32_fp8((int)g.y, true);
#define SG_(x) __builtin_amdgcn_rcpf(1.0f + __builtin_amdgcn_exp2f(x))
                    float o[8];
                    o[0] = bf_lo(p.x) + SG_(g0[0]) * v0[0]; o[1] = bf_hi(p.x) + SG_(g0[1]) * v0[1];
                    o[2] = bf_lo(p.y) + SG_(g1[0]) * v0[2]; o[3] = bf_hi(p.y) + SG_(g1[1]) * v0[3];
                    o[4] = bf_lo(p.z) + SG_(g2[0]) * v1[0]; o[5] = bf_hi(p.z) + SG_(g2[1]) * v1[1];
                    o[6] = bf_lo(p.w) + SG_(g3[0]) * v1[2]; o[7] = bf_hi(p.w) + SG_(g3[1]) * v1[3];
#undef SG_
                    if (u.z != 2) { u32x4 w; w.x = cvt_pk_bf16(o[0], o[1]); w.y = cvt_pk_bf16(o[2], o[3]); w.z = cvt_pk_bf16(o[4], o[5]); w.w = cvt_pk_bf16(o[6], o[7]);
                        *(u32x4*)(rowp + bj * HALF) = w; }
                    else { int w0 = 0, w1 = 0; w0 = __builtin_amdgcn_cvt_pk_fp8_f32(o[0] * oscale, o[1] * oscale, w0, false); w0 = __builtin_amdgcn_cvt_pk_fp8_f32(o[2] * oscale, o[3] * oscale, w0, true);
                        w1 = __builtin_amdgcn_cvt_pk_fp8_f32(o[4] * oscale, o[5] * oscale, w1, false); w1 = __builtin_amdgcn_cvt_pk_fp8_f32(o[6] * oscale, o[7] * oscale, w1, true);
                        *(u32x2*)(r8 + bj * HALF) = (u32x2){(unsigned)w0, (unsigned)w1}; } } }
        }
    }
};

typedef int i32x4 __attribute__((ext_vector_type(4)));
typedef int i32x8 __attribute__((ext_vector_type(8)));
template <class Epi, bool ALIGN_EPI, bool SP2, bool FP8 = false>
__device__ __forceinline__ void gemm_phase(PG8_LAS unsigned char* lds, const Gemm g, const StaticOrder& S, const Epi& E) {
    int tid_ = threadIdx.x; asm volatile("" : "+v"(tid_));
    const int tid = tid_, wid = __builtin_amdgcn_readfirstlane(tid >> 6), lane = tid & 63, wr = wid >> 2, wc = wid & 3, fr = lane & 15, fq = lane >> 4;
    const int K = g.K, nt = K / BK, lda = g.lda;
    unsigned voffA[2], voffB[2];
#pragma unroll
    for (int i = 0; i < 2; ++i) { int R, C; stage_rc(tid * 16 + i * 8192, R, C); const int Rb = Epi::PERM ? ((R & ~31) + perm32(R & 31)) : R;
        voffA[i] = (unsigned)(R * lda + C) * 2u; voffB[i] = (unsigned)(Rb * K + C) * 2u; }
    const size_t kstep = (size_t)(BK * 2), kstepA = (size_t)g.kstepA;
    const size_t hstepA = (size_t)HALF * lda * 2, hstepB = (size_t)HALF * K * 2;
    const unsigned ldsw = (unsigned)wid * 1024u;
    const int aoff = lds_byte(wr * 64 + fr, fq * 8), boff = lds_byte(wc * 32 + fr, fq * 8);
#define PG8_SA(b, h) (((b) * 2 + (h)) * HTB)
#define PG8_SB(b, h) ((4 + (b) * 2 + (h)) * HTB)
#define PG8_STAGE(bufoff, gbase, voff) do { _Pragma("unroll") for (int _i = 0; _i < 2; ++_i) \
        __builtin_amdgcn_global_load_lds((const unsigned*)((const char*)(gbase) + (voff)[_i]), (PG8_LAS unsigned*)(lds + (bufoff) + ldsw + _i * 8192), 16, 0, 0); } while (0)
#define PG8_LDA(dst, b, h) do { _Pragma("unroll") for (int m = 0; m < 4; ++m) { const i32x4 lo_ = *(const PG8_LAS i32x4*)(lds + PG8_SA(b, h) + aoff + m * 2048), hi_ = *(const PG8_LAS i32x4*)(lds + PG8_SA(b, h) + aoff + m * 2048 + 1024); dst[m] = __builtin_shufflevector(lo_, hi_, 0, 1, 2, 3, 4, 5, 6, 7); } } while (0)
#define PG8_LDB(dst, b, h) do { _Pragma("unroll") for (int n = 0; n < 2; ++n) { const i32x4 lo_ = *(const PG8_LAS i32x4*)(lds + PG8_SB(b, h) + boff + n * 2048), hi_ = *(const PG8_LAS i32x4*)(lds + PG8_SB(b, h) + boff + n * 2048 + 1024); dst[n] = __builtin_shufflevector(lo_, hi_, 0, 1, 2, 3, 4, 5, 6, 7); } } while (0)
#define PG8_LO(x) __builtin_bit_cast(bf16x8, __builtin_shufflevector(x, x, 0, 1, 2, 3))
#define PG8_HI(x) __builtin_bit_cast(bf16x8, __builtin_shufflevector(x, x, 4, 5, 6, 7))
#define PG8_MMA(ai, bj, At, Bt) do { __builtin_amdgcn_s_setprio(1); if constexpr (FP8) { _Pragma("unroll") for (int m = 0; m < 4; ++m) _Pragma("unroll") for (int n = 0; n < 2; ++n) \
        asm volatile("v_mfma_scale_f32_16x16x128_f8f6f4 %0, %1, %2, %0, %3, %3 op_sel_hi:[0,0,0]" : "+v"(acc[ai][bj][m][n]) : "v"(Bt[n]), "v"(At[m]), "v"(one_scale)); } else { \
        _Pragma("unroll") for (int m = 0; m < 4; ++m) _Pragma("unroll") for (int n = 0; n < 2; ++n) { \
        acc[ai][bj][m][n] = __builtin_amdgcn_mfma_f32_16x16x32_bf16(PG8_LO(Bt[n]), PG8_LO(At[m]), acc[ai][bj][m][n], 0, 0, 0); \
        acc[ai][bj][m][n] = __builtin_amdgcn_mfma_f32_16x16x32_bf16(PG8_HI(Bt[n]), PG8_HI(At[m]), acc[ai][bj][m][n], 0, 0, 0); } } __builtin_amdgcn_s_setprio(0); } while (0)
#define PG8_WAIT_V(n) asm volatile("s_waitcnt vmcnt(" #n ")" ::: "memory")
#define PG8_WAIT_VN(N) asm volatile("s_waitcnt vmcnt(%0)" :: "n"(N) : "memory")
#define PG8_WAIT_L(n) asm volatile("s_waitcnt lgkmcnt(" #n ")" ::: "memory")
#define PG8_BAR __builtin_amdgcn_s_barrier()
#define PG8_SCHED __builtin_amdgcn_sched_barrier(0)
    Unit cur, nxt; int ui = 0;
    if (!S.next(0, cur)) return;
    f32x4 acc[2][2][4][2];
#pragma unroll
    for (int a = 0; a < 2; ++a)
#pragma unroll
        for (int b = 0; b < 2; ++b)
#pragma unroll
            for (int m = 0; m < 4; ++m)
#pragma unroll
                for (int n = 0; n < 2; ++n) acc[a][b][m][n] = (f32x4){0.f, 0.f, 0.f, 0.f};
    i32x8 At[4], B0[2], B1[2];
    const int one_scale = 0x7F7F7F7F;
    const char* cA = (const char*)g.A + E.aoff(cur, lda); const char* cB = (const char*)g.Bt + E.boff(cur, K);
    if constexpr (SP2) {
        PG8_STAGE(PG8_SB(0, 0), cB, voffB); PG8_STAGE(PG8_SB(0, 1), cB + hstepB, voffB); PG8_STAGE(PG8_SA(0, 0), cA, voffA); PG8_STAGE(PG8_SA(0, 1), cA + hstepA, voffA);
        if (wr == 1) PG8_BAR;
        PG8_WAIT_V(2); PG8_BAR;
        PG8_STAGE(PG8_SB(1, 0), cB + kstep, voffB); PG8_STAGE(PG8_SA(1, 0), cA + kstepA, voffA); PG8_STAGE(PG8_SB(1, 1), cB + hstepB + kstep, voffB);
        PG8_WAIT_V(6); PG8_BAR;
    } else {
        PG8_STAGE(PG8_SB(0, 0), cB, voffB); PG8_STAGE(PG8_SA(0, 0), cA, voffA); PG8_STAGE(PG8_SB(0, 1), cB + hstepB, voffB); PG8_STAGE(PG8_SA(0, 1), cA + hstepA, voffA);
        if (wr == 1) PG8_BAR;
        PG8_WAIT_V(4); PG8_BAR;
        PG8_STAGE(PG8_SB(1, 0), cB + kstep, voffB); PG8_STAGE(PG8_SA(1, 0), cA + kstepA, voffA); PG8_STAGE(PG8_SB(1, 1), cB + hstepB + kstep, voffB);
        PG8_WAIT_V(6); PG8_BAR;
    }
    for (;;) {
        const bool has_next = S.next(ui + 1, nxt);
        const char* nA = has_next ? (const char*)g.A + E.aoff(nxt, lda) : cA; const char* nB = has_next ? (const char*)g.Bt + E.boff(nxt, K) : cB;
        for (int t = 0; t < nt; t += 2) {
            const bool last = (t == nt - 2);
            const char* a1 = cA + (size_t)(t + 1) * kstepA;
            const char* a2 = last ? nA : cA + (size_t)(t + 2) * kstepA; const char* b2 = last ? nB : cB + (size_t)(t + 2) * kstep;
            const char* a3 = a2 + kstepA; const char* b3 = b2 + kstep;
            if constexpr (SP2) {
            int relax_ = __builtin_amdgcn_readfirstlane(((t == 0) && (ui > 0)) ? 1 : 0); asm volatile("" : "+s"(relax_));
#define PG8_WAIT_R() do { if (relax_) PG8_WAIT_VN(8 + Epi::NST); else PG8_WAIT_V(8); } while (0)
            PG8_LDB(B0, 0, 0); PG8_LDB(B1, 0, 1); PG8_SCHED; PG8_LDA(At, 0, 0); PG8_STAGE(PG8_SA(1, 1), a1 + hstepA, voffA);
            PG8_WAIT_R(); PG8_WAIT_L(0); PG8_BAR; PG8_MMA(0, 0, At, B0); PG8_MMA(0, 1, At, B1); PG8_BAR; PG8_SCHED;
            PG8_LDA(At, 0, 1); PG8_STAGE(PG8_SB(0, 0), b2, voffB); PG8_STAGE(PG8_SB(0, 1), b2 + hstepB, voffB); PG8_STAGE(PG8_SA(0, 0), a2, voffA);
            PG8_WAIT_R(); PG8_WAIT_L(0); PG8_BAR; PG8_MMA(1, 0, At, B0); PG8_MMA(1, 1, At, B1); PG8_BAR; PG8_SCHED;
#undef PG8_WAIT_R
            PG8_LDB(B0, 1, 0); PG8_LDB(B1, 1, 1); PG8_SCHED; PG8_LDA(At, 1, 0); PG8_STAGE(PG8_SA(0, 1), a2 + hstepA, voffA);
            PG8_WAIT_V(8); PG8_WAIT_L(0); PG8_BAR; PG8_MMA(0, 0, At, B0); PG8_MMA(0, 1, At, B1); PG8_BAR; PG8_SCHED;
            PG8_LDA(At, 1, 1); PG8_STAGE(PG8_SB(1, 0), b3, voffB); PG8_STAGE(PG8_SB(1, 1), b3 + hstepB, voffB); PG8_STAGE(PG8_SA(1, 0), a3, voffA);
            PG8_WAIT_V(8); PG8_WAIT_L(0); PG8_BAR; PG8_MMA(1, 0, At, B0); PG8_MMA(1, 1, At, B1); PG8_BAR; PG8_SCHED;
            } else {
            PG8_LDB(B0, 0, 0); PG8_SCHED; PG8_LDA(At, 0, 0); PG8_STAGE(PG8_SA(1, 1), a1 + hstepA, voffA);
            PG8_WAIT_L(8); PG8_BAR; PG8_WAIT_L(0); PG8_MMA(0, 0, At, B0); PG8_BAR; PG8_SCHED;
            PG8_LDB(B1, 0, 1); PG8_STAGE(PG8_SB(0, 0), b2, voffB);
            PG8_BAR; PG8_WAIT_L(0); PG8_MMA(0, 1, At, B1); PG8_BAR;
            PG8_LDA(At, 0, 1); PG8_STAGE(PG8_SA(0, 0), a2, voffA);
            PG8_BAR; PG8_WAIT_L(0); PG8_MMA(1, 0, At, B0); PG8_BAR; PG8_SCHED;
            PG8_STAGE(PG8_SB(0, 1), b2 + hstepB, voffB);
            PG8_WAIT_V(6); PG8_BAR; PG8_MMA(1, 1, At, B1); PG8_BAR;
            PG8_LDB(B0, 1, 0); PG8_SCHED; PG8_LDA(At, 1, 0); PG8_STAGE(PG8_SA(0, 1), a2 + hstepA, voffA);
            PG8_WAIT_L(8); PG8_BAR; PG8_WAIT_L(0); PG8_MMA(0, 0, At, B0); PG8_BAR; PG8_SCHED;
            PG8_LDB(B1, 1, 1); PG8_STAGE(PG8_SB(1, 0), b3, voffB);
            PG8_BAR; PG8_WAIT_L(0); PG8_MMA(0, 1, At, B1); PG8_BAR;
            PG8_LDA(At, 1, 1); PG8_STAGE(PG8_SA(1, 0), a3, voffA);
            PG8_BAR; PG8_WAIT_L(0); PG8_MMA(1, 0, At, B0); PG8_BAR; PG8_SCHED;
            PG8_STAGE(PG8_SB(1, 1), b3 + hstepB, voffB);
            PG8_WAIT_V(6); PG8_BAR; PG8_MMA(1, 1, At, B1); PG8_BAR;
            }
        }
        if constexpr (ALIGN_EPI) { if (wr == 0) PG8_BAR; }
        if constexpr (FP8) {
            asm volatile("s_nop 15\n\ts_nop 15" : "+v"(acc[0][0][0][0]), "+v"(acc[0][0][0][1]), "+v"(acc[0][0][1][0]), "+v"(acc[0][0][1][1]), "+v"(acc[0][0][2][0]), "+v"(acc[0][0][2][1]), "+v"(acc[0][0][3][0]), "+v"(acc[0][0][3][1]),
                         "+v"(acc[0][1][0][0]), "+v"(acc[0][1][0][1]), "+v"(acc[0][1][1][0]), "+v"(acc[0][1][1][1]), "+v"(acc[0][1][2][0]), "+v"(acc[0][1][2][1]), "+v"(acc[0][1][3][0]), "+v"(acc[0][1][3][1]));
            asm volatile("" : "+v"(acc[1][0][0][0]), "+v"(acc[1][0][0][1]), "+v"(acc[1][0][1][0]), "+v"(acc[1][0][1][1]), "+v"(acc[1][0][2][0]), "+v"(acc[1][0][2][1]), "+v"(acc[1][0][3][0]), "+v"(acc[1][0][3][1]),
                         "+v"(acc[1][1][0][0]), "+v"(acc[1][1][0][1]), "+v"(acc[1][1][1][0]), "+v"(acc[1][1][1][1]), "+v"(acc[1][1][2][0]), "+v"(acc[1][1][2][1]), "+v"(acc[1][1][3][0]), "+v"(acc[1][1][3][1])); }
        E(acc, cur, wr, wc, fr, fq);
        if (!has_next) break;
#pragma unroll
        for (int a = 0; a < 2; ++a)
#pragma unroll
            for (int b = 0; b < 2; ++b)
#pragma unroll
                for (int m = 0; m < 4; ++m)
#pragma unroll
                    for (int n = 0; n < 2; ++n) acc[a][b][m][n] = (f32x4){0.f, 0.f, 0.f, 0.f};
        cur = nxt; cA = nA; cB = nB; ++ui;
        if constexpr (ALIGN_EPI) { if (wr == 1) PG8_BAR; }
    }
    PG8_WAIT_V(0);
    if constexpr (!ALIGN_EPI) { if (wr == 0) PG8_BAR; }
    PG8_BAR;
#undef PG8_SA
#undef PG8_SB
#undef PG8_STAGE
#undef PG8_LDA
#undef PG8_LDB
#undef PG8_MMA
#undef PG8_LO
#undef PG8_HI
#undef PG8_WAIT_V
#undef PG8_WAIT_VN
#undef PG8_WAIT_L
#undef PG8_BAR
#undef PG8_SCHED
}
}
namespace att {
#define ATT_LAS __attribute__((address_space(3)))
typedef unsigned short bf16;
using bf16x8 = __attribute__((ext_vector_type(8))) short;
using s16x4  = __attribute__((ext_vector_type(4))) short;
using f32x16 = __attribute__((ext_vector_type(16))) float;
using u32x4  = __attribute__((ext_vector_type(4))) unsigned;
using i32x4  = __attribute__((ext_vector_type(4))) int;
using i32x8  = __attribute__((ext_vector_type(8))) int;
constexpr int NW = 8, QBLK = 32, KVBLK = 64;
constexpr int SHM_V = 16384, SHM_K = 16384, SHM_KR = 8192;
constexpr int OFF_V = 0, OFF_K = 2 * SHM_V, OFF_KR = OFF_K + 2 * SHM_K, OFF_WS = OFF_KR + 2 * SHM_KR, OFF_TAB = OFF_WS + NW * 64 * 4, ATT_LDS_BYTES = OFF_TAB + 15 * 128 * 4, OFF_OST = 98304  ;
constexpr float YS = 8.0f;
static_assert(ATT_LDS_BYTES <= OFF_OST, "attention LDS map");
#define KSWZ(row, colB) ((row) * 256 + ((colB) ^ (((row) & 7) << 4)))
#define KRSWZ(row, colB) ((row) * 128 + ((colB) ^ (((row) & 7) << 4)))
#define K8SWZ(row, colB) ((row) * 128 + ((colB) ^ ((((row) >> 1) & 7) << 4)))
#define SBAR() __builtin_amdgcn_sched_barrier(0)
__device__ __forceinline__ int crow(int r, int hi) { return (r & 3) + 8 * (r >> 2) + 4 * hi; }
__device__ __forceinline__ unsigned cvtpk(float lo, float hi) { unsigned r; asm volatile("v_cvt_pk_bf16_f32 %0, %1, %2" : "=v"(r) : "v"(lo), "v"(hi)); return r; }

template <int DQK> struct Sc { static constexpr float SCALE = (DQK == 192) ? 0.07216878364870322f : 0.08838834764831845f; };

template <int DQK, int F8>
__device__ __forceinline__ void partialSM(f32x16& p0, f32x16& p1, float& m_reg, float& mn, float& alpha) {
  constexpr float SCALE = Sc<DQK>::SCALE; constexpr float C = SCALE * 1.4426950408889634f; constexpr float THR = F8 ? 3.f : 8.f;
  float pmax = p0[0];
#pragma unroll
  for (int r = 1; r < 16; ++r) pmax = fmaxf(pmax, p0[r]);
#pragma unroll
  for (int r = 0; r < 16; ++r) pmax = fmaxf(pmax, p1[r]);
  { auto rr = __builtin_amdgcn_permlane32_swap(__float_as_uint(pmax), __float_as_uint(pmax), false, false);
    pmax = fmaxf(__uint_as_float(rr[0]), __uint_as_float(rr[1])); }
  if (__builtin_expect(__all(pmax - m_reg <= THR / SCALE), 1)) { mn = m_reg; alpha = 1.f; }
  else { mn = fmaxf(m_reg, pmax); alpha = __builtin_amdgcn_exp2f((m_reg - mn) * C); m_reg = mn; }
  float mnC = -mn * C + (F8 ? 4.f : 0.f);
#pragma unroll
  for (int r = 0; r < 16; ++r) p0[r] = fmaf(p0[r], C, mnC);
#pragma unroll
  for (int r = 0; r < 16; ++r) p1[r] = fmaf(p1[r], C, mnC);
#pragma unroll
  for (int r = 0; r < 16; ++r) p0[r] = __builtin_amdgcn_exp2f(p0[r]);
}
__device__ __forceinline__ void finishSM(f32x16& p0, f32x16& p1, float alpha, float& l_reg, bf16x8& pa0, bf16x8& pa1, bf16x8& pa2, bf16x8& pa3) {
#pragma unroll
  for (int r = 0; r < 16; ++r) p1[r] = __builtin_amdgcn_exp2f(p1[r]);
  float ps = 0;
#pragma unroll
  for (int r = 0; r < 16; ++r) ps += p0[r];
#pragma unroll
  for (int r = 0; r < 16; ++r) ps += p1[r];
  { auto rr = __builtin_amdgcn_permlane32_swap(__float_as_uint(ps), __float_as_uint(ps), false, false);
    ps = __uint_as_float(rr[0]) + __uint_as_float(rr[1]); }
  l_reg = l_reg * alpha + ps;
#define PK4(P, BASE, OUT) do { unsigned a0 = cvtpk(P[BASE + 0], P[BASE + 1]), a1 = cvtpk(P[BASE + 2], P[BASE + 3]);   \
    unsigned b0 = cvtpk(P[BASE + 4], P[BASE + 5]), b1 = cvtpk(P[BASE + 6], P[BASE + 7]);                              \
    auto r0 = __builtin_amdgcn_permlane32_swap(a0, b0, false, false); auto r1 = __builtin_amdgcn_permlane32_swap(a1, b1, false, false); \
    u32x4 w = {r0[0], r1[0], r0[1], r1[1]}; OUT = *reinterpret_cast<bf16x8*>(&w); } while (0)
  PK4(p0, 0, pa0); PK4(p0, 8, pa1); PK4(p1, 0, pa2); PK4(p1, 8, pa3);
#undef PK4
}
template <int DQK>
__device__ __forceinline__ void qkt(f32x16& p0, f32x16& p1, const ATT_LAS char* Ks, const ATT_LAS char* Krs, const bf16x8* qr, const ATT_LAS char* Qrs, int r32, int hi) {
  p0 = f32x16{}; p1 = f32x16{};
#pragma unroll
  for (int d0 = 0; d0 < 8; ++d0) { int cb = (d0 * 16 + hi * 8) * 2;
    bf16x8 b0 = *reinterpret_cast<const ATT_LAS bf16x8*>(Ks + KSWZ(r32, cb));
    bf16x8 b1 = *reinterpret_cast<const ATT_LAS bf16x8*>(Ks + KSWZ(32 + r32, cb));
    p0 = __builtin_amdgcn_mfma_f32_32x32x16_bf16(b0, qr[d0], p0, 0, 0, 0);
    p1 = __builtin_amdgcn_mfma_f32_32x32x16_bf16(b1, qr[d0], p1, 0, 0, 0); }
  if constexpr (DQK == 192) {
#pragma unroll
    for (int d0 = 0; d0 < 4; ++d0) { int cb = (d0 * 16 + hi * 8) * 2;
      bf16x8 b0 = *reinterpret_cast<const ATT_LAS bf16x8*>(Krs + KRSWZ(r32, cb));
      bf16x8 b1 = *reinterpret_cast<const ATT_LAS bf16x8*>(Krs + KRSWZ(32 + r32, cb));
      p0 = __builtin_amdgcn_mfma_f32_32x32x16_bf16(b0, qr[8 + d0], p0, 0, 0, 0);
      p1 = __builtin_amdgcn_mfma_f32_32x32x16_bf16(b1, qr[8 + d0], p1, 0, 0, 0); }
  }
}
#define KR8SWZ(row, c16) ((row) * 64 + ((((c16) ^ (((row) >> 2) & 3))) << 4))
template <int DQK>
__device__ __forceinline__ void qkt8(f32x16& p0, f32x16& p1, const ATT_LAS char* Ks, const ATT_LAS char* Krs, const i32x8 (&q8)[DQK / 64], int r32, int hi) {
  const int one = 0x7F7F7F7F;
#define LD32(dst, base, o0, o1) const i32x4 dst##_l = *reinterpret_cast<const ATT_LAS i32x4*>((base) + (o0)), dst##_h = *reinterpret_cast<const ATT_LAS i32x4*>((base) + (o1)); const i32x8 dst = __builtin_shufflevector(dst##_l, dst##_h, 0, 1, 2, 3, 4, 5, 6, 7)
  { const int cb = hi * 32;
    LD32(a0, Ks, K8SWZ(r32, cb), K8SWZ(r32, cb + 16)); LD32(a1, Ks, K8SWZ(32 + r32, cb), K8SWZ(32 + r32, cb + 16));
    asm volatile("v_mfma_scale_f32_32x32x64_f8f6f4 %0, %1, %2, 0, %3, %3 op_sel_hi:[0,0,0]" : "=&v"(p0) : "v"(a0), "v"(q8[0]), "v"(one));
    asm volatile("v_mfma_scale_f32_32x32x64_f8f6f4 %0, %1, %2, 0, %3, %3 op_sel_hi:[0,0,0]" : "=&v"(p1) : "v"(a1), "v"(q8[0]), "v"(one)); }
  { const int cb = 64 + hi * 32;
    LD32(a0, Ks, K8SWZ(r32, cb), K8SWZ(r32, cb + 16)); LD32(a1, Ks, K8SWZ(32 + r32, cb), K8SWZ(32 + r32, cb + 16));
    asm volatile("v_mfma_scale_f32_32x32x64_f8f6f4 %0, %1, %2, %0, %3, %3 op_sel_hi:[0,0,0]" : "+v"(p0) : "v"(a0), "v"(q8[1]), "v"(one));
    asm volatile("v_mfma_scale_f32_32x32x64_f8f6f4 %0, %1, %2, %0, %3, %3 op_sel_hi:[0,0,0]" : "+v"(p1) : "v"(a1), "v"(q8[1]), "v"(one)); }
  if constexpr (DQK == 192) {
    LD32(a0, Krs, KR8SWZ(r32, 2 * hi), KR8SWZ(r32, 2 * hi + 1)); LD32(a1, Krs, KR8SWZ(32 + r32, 2 * hi), KR8SWZ(32 + r32, 2 * hi + 1));
    asm volatile("v_mfma_scale_f32_32x32x64_f8f6f4 %0, %1, %2, %0, %3, %3 op_sel_hi:[0,0,0]" : "+v"(p0) : "v"(a0), "v"(q8[DQK / 64 - 1]), "v"(one));
    asm volatile("v_mfma_scale_f32_32x32x64_f8f6f4 %0, %1, %2, %0, %3, %3 op_sel_hi:[0,0,0]" : "+v"(p1) : "v"(a1), "v"(q8[DQK / 64 - 1]), "v"(one)); }
#undef LD32
  asm volatile("s_nop 15\n\ts_nop 7" : "+v"(p0), "+v"(p1));
}
__device__ __forceinline__ int v_st(int k, int c) { const int kk = (k & ~0xC) | ((k & 4) << 1) | ((k & 8) >> 1); return ((kk >> 3) * 4 + (c >> 5)) * 512 + ((kk & 7) * 32 + (c & 31)) * 2; }
__device__ __forceinline__ int v_rd_base(int lane) { return ((lane & 3) << 3) | (((lane >> 2) & 3) << 6) | (((lane >> 4) & 1) << 5) | (((lane >> 5) & 1) << 8); }
constexpr int v_rd_off(int d0, int ks, int half) { return d0 * 512 + ks * 4096 + half * 2048; }
template <int OFF> __device__ __forceinline__ s16x4 tr_read(int vb) {
  s16x4 r; asm volatile("ds_read_b64_tr_b16 %0, %1 offset:%2" : "=&v"(r) : "v"(vb), "i"(OFF) : "memory"); return r;
}
template <int D0> __device__ __forceinline__ void pv_one(f32x16& od, int vb, bf16x8 pa0, bf16x8 pa1, bf16x8 pa2, bf16x8 pa3) {
  const s16x4 l0 = tr_read<v_rd_off(D0, 0, 0)>(vb), h0 = tr_read<v_rd_off(D0, 0, 1)>(vb), l1 = tr_read<v_rd_off(D0, 1, 0)>(vb), h1 = tr_read<v_rd_off(D0, 1, 1)>(vb);
  const s16x4 l2 = tr_read<v_rd_off(D0, 2, 0)>(vb), h2 = tr_read<v_rd_off(D0, 2, 1)>(vb), l3 = tr_read<v_rd_off(D0, 3, 0)>(vb), h3 = tr_read<v_rd_off(D0, 3, 1)>(vb);
  asm volatile("s_waitcnt lgkmcnt(0)" ::: "memory"); SBAR();
#define PK(L, H) (bf16x8){L[0], L[1], L[2], L[3], H[0], H[1], H[2], H[3]}
  od = __builtin_amdgcn_mfma_f32_32x32x16_bf16(pa0, PK(l0, h0), od, 0, 0, 0);
  od = __builtin_amdgcn_mfma_f32_32x32x16_bf16(pa1, PK(l1, h1), od, 0, 0, 0);
  od = __builtin_amdgcn_mfma_f32_32x32x16_bf16(pa2, PK(l2, h2), od, 0, 0, 0);
  od = __builtin_amdgcn_mfma_f32_32x32x16_bf16(pa3, PK(l3, h3), od, 0, 0, 0);
#undef PK
}
__device__ __forceinline__ void pv_d0(f32x16* o, int vb, bf16x8 pa0, bf16x8 pa1, bf16x8 pa2, bf16x8 pa3) {
  pv_one<0>(o[0], vb, pa0, pa1, pa2, pa3); pv_one<1>(o[1], vb, pa0, pa1, pa2, pa3); pv_one<2>(o[2], vb, pa0, pa1, pa2, pa3); pv_one<3>(o[3], vb, pa0, pa1, pa2, pa3);
}

__device__ __forceinline__ void finishSM8(f32x16& p0, f32x16& p1, float alpha, float& l_reg, i32x8& P8) {
#pragma unroll
  for (int r = 0; r < 16; ++r) p1[r] = __builtin_amdgcn_exp2f(p1[r]);
  float ps = 0;
#pragma unroll
  for (int r = 0; r < 16; ++r) ps += p0[r];
#pragma unroll
  for (int r = 0; r < 16; ++r) ps += p1[r];
  { auto rr = __builtin_amdgcn_permlane32_swap(__float_as_uint(ps), __float_as_uint(ps), false, false);
    ps = __uint_as_float(rr[0]) + __uint_as_float(rr[1]); }
  l_reg = l_reg * alpha + ps;
  int w[8];
#pragma unroll
  for (int k = 0; k < 4; ++k) { int x = 0; x = __builtin_amdgcn_cvt_pk_fp8_f32(p0[4 * k], p0[4 * k + 1], x, false); x = __builtin_amdgcn_cvt_pk_fp8_f32(p0[4 * k + 2], p0[4 * k + 3], x, true); w[k] = x;
    int y = 0; y = __builtin_amdgcn_cvt_pk_fp8_f32(p1[4 * k], p1[4 * k + 1], y, false); y = __builtin_amdgcn_cvt_pk_fp8_f32(p1[4 * k + 2], p1[4 * k + 3], y, true); w[4 + k] = y; }
  P8 = (i32x8){w[0], w[1], w[2], w[3], w[4], w[5], w[6], w[7]};
}
using u32x2 = __attribute__((ext_vector_type(2))) unsigned;
template <int OFF> __device__ __forceinline__ u32x2 tr8_read(int vb) {
  u32x2 r; asm volatile("ds_read_b64_tr_b8 %0, %1 offset:%2" : "=&v"(r) : "v"(vb), "i"(OFF) : "memory"); return r;
}
template <bool LAST> __device__ __forceinline__ void pv8_one(f32x16& od, int vb, const i32x8& P8) {
  const u32x2 r0 = tr8_read<0>(vb), r1 = tr8_read<2048>(vb), r2 = tr8_read<4096>(vb), r3 = tr8_read<6144>(vb);
  asm volatile("s_waitcnt lgkmcnt(0)" ::: "memory"); SBAR();
  const i32x8 vf = (i32x8){(int)r0.x, (int)r0.y, (int)r1.x, (int)r1.y, (int)r2.x, (int)r2.y, (int)r3.x, (int)r3.y};
  const int one = 0x7F7F7F7F;
  asm volatile("v_mfma_scale_f32_32x32x64_f8f6f4 %0, %1, %2, %0, %3, %3 op_sel_hi:[0,0,0]" : "+v"(od) : "v"(P8), "v"(vf), "v"(one));
}
__device__ __forceinline__ void pv8(f32x16* o, const int (&vb)[4], int boff, const i32x8& P8) {
  pv8_one<false>(o[0], vb[0] + boff, P8); pv8_one<false>(o[1], vb[1] + boff, P8); pv8_one<false>(o[2], vb[2] + boff, P8); pv8_one<true>(o[3], vb[3] + boff, P8);
  asm volatile("s_nop 15\n\ts_nop 7" : "+v"(o[0]), "+v"(o[1]), "+v"(o[2]), "+v"(o[3]));
}


#define ATT_LD32(dst, base, o0, o1) const i32x4 dst##_l = *reinterpret_cast<const ATT_LAS i32x4*>((base) + (o0)), dst##_h = *reinterpret_cast<const ATT_LAS i32x4*>((base) + (o1)); const i32x8 dst = __builtin_shufflevector(dst##_l, dst##_h, 0, 1, 2, 3, 4, 5, 6, 7)
#define ATT_MF0(ACC, A_, B_, TIE) asm volatile("v_mfma_scale_f32_32x32x64_f8f6f4 %0, %2, %3, 0, %4, %4 op_sel_hi:[0,0,0]" : "=&v"(ACC), "+v"(TIE) : "v"(A_), "v"(B_), "v"(one) : "memory")
#define ATT_MF1(ACC, A_, B_, TIE) asm volatile("v_mfma_scale_f32_32x32x64_f8f6f4 %0, %2, %3, %0, %4, %4 op_sel_hi:[0,0,0]" : "+v"(ACC), "+v"(TIE) : "v"(A_), "v"(B_), "v"(one) : "memory")
#define ATT_MF2(ACC, A_, B_, T0, T1) asm volatile("v_mfma_scale_f32_32x32x64_f8f6f4 %0, %3, %4, %0, %5, %5 op_sel_hi:[0,0,0]" : "+v"(ACC), "+v"(T0), "+v"(T1) : "v"(A_), "v"(B_), "v"(one))
template <int A, int B> __device__ __forceinline__ void exp_rng(f32x16& p) {
#pragma unroll
  for (int r = A; r < B; ++r) p[r] = __builtin_amdgcn_exp2f(p[r]);
}
template <int DQK>
__device__ __forceinline__ void fusedA(f32x16& n0, f32x16& n1, const ATT_LAS char* Ks, const ATT_LAS char* Krs, const i32x8 (&q8)[DQK / 64], int r32, int hi, f32x16& pp0, f32x16& pp1, float alp, float& l_reg, i32x8& P8) {
  const int one = 0x7F7F7F7F;
  const int cb = hi * 32, cc = 64 + hi * 32;
  ATT_LD32(a0, Ks, K8SWZ(r32, cb), K8SWZ(r32, cb + 16)); ATT_LD32(a1, Ks, K8SWZ(32 + r32, cb), K8SWZ(32 + r32, cb + 16));
  if constexpr (DQK == 192) {
    ATT_MF0(n0, a0, q8[0], pp1); ATT_LD32(b0, Ks, K8SWZ(r32, cc), K8SWZ(r32, cc + 16)); exp_rng<0, 3>(pp1);
    ATT_MF0(n1, a1, q8[0], pp1); ATT_LD32(b1, Ks, K8SWZ(32 + r32, cc), K8SWZ(32 + r32, cc + 16)); exp_rng<3, 6>(pp1);
    ATT_MF1(n0, b0, q8[1], pp1); ATT_LD32(c0, Krs, KR8SWZ(r32, 2 * hi), KR8SWZ(r32, 2 * hi + 1)); exp_rng<6, 9>(pp1);
    ATT_MF1(n1, b1, q8[1], pp1); ATT_LD32(c1, Krs, KR8SWZ(32 + r32, 2 * hi), KR8SWZ(32 + r32, 2 * hi + 1)); exp_rng<9, 12>(pp1);
    ATT_MF1(n0, c0, q8[2], pp1); exp_rng<12, 14>(pp1);
    ATT_MF1(n1, c1, q8[2], pp1); exp_rng<14, 16>(pp1);
  } else {
    ATT_MF0(n0, a0, q8[0], pp1); ATT_LD32(b0, Ks, K8SWZ(r32, cc), K8SWZ(r32, cc + 16)); exp_rng<0, 4>(pp1);
    ATT_MF0(n1, a1, q8[0], pp1); ATT_LD32(b1, Ks, K8SWZ(32 + r32, cc), K8SWZ(32 + r32, cc + 16)); exp_rng<4, 8>(pp1);
    ATT_MF1(n0, b0, q8[1], pp1); exp_rng<8, 12>(pp1);
    ATT_MF1(n1, b1, q8[1], pp1); exp_rng<12, 16>(pp1);
  }
  typedef float f32x2_ __attribute__((ext_vector_type(2)));
  f32x2_ ps2 = {pp0[0], pp0[1]};
#pragma unroll
  for (int r = 2; r < 16; r += 2) ps2 += (f32x2_){pp0[r], pp0[r + 1]};
#pragma unroll
  for (int r = 0; r < 16; r += 2) ps2 += (f32x2_){pp1[r], pp1[r + 1]};
  float ps = ps2.x + ps2.y;
  { auto rr = __builtin_amdgcn_permlane32_swap(__float_as_uint(ps), __float_as_uint(ps), false, false);
    ps = __uint_as_float(rr[0]) + __uint_as_float(rr[1]); }
  l_reg = l_reg * alp + ps;
  int w[8];
#pragma unroll
  for (int k = 0; k < 4; ++k) { int x = 0; x = __builtin_amdgcn_cvt_pk_fp8_f32(pp0[4 * k], pp0[4 * k + 1], x, false); x = __builtin_amdgcn_cvt_pk_fp8_f32(pp0[4 * k + 2], pp0[4 * k + 3], x, true); w[k] = x;
    int y = 0; y = __builtin_amdgcn_cvt_pk_fp8_f32(pp1[4 * k], pp1[4 * k + 1], y, false); y = __builtin_amdgcn_cvt_pk_fp8_f32(pp1[4 * k + 2], pp1[4 * k + 3], y, true); w[4 + k] = y; }
  P8 = (i32x8){w[0], w[1], w[2], w[3], w[4], w[5], w[6], w[7]};
}
struct AttnUnit {
  const bf16* Q; int ldq;
  const bf16* Kn; int ldkv;
  const bf16* Kr; int ldkr;
  const bf16* V;
  const unsigned char* K8; int ldk8;
  const unsigned char* Kr8;
  const unsigned char* V8; int ldv8;
  bf16* O; int ldo;
  int NT, n0, base0, base1;
  const float* rpb;
  int qrow0, krow0;
};

template <int DQK, int MODE, int K8, int Q8 = 0>
__device__ __forceinline__ void attn_body(const AttnUnit& U, ATT_LAS char* lds, const AttnUnit& N, bool has_next, bool pre) {
  constexpr float SCALE = Sc<DQK>::SCALE; constexpr int NQR = DQK / 16;
  int tid_ = threadIdx.x; asm volatile("" : "+v"(tid_));
  const int tid = tid_, wid = __builtin_amdgcn_readfirstlane(tid >> 6), lane = tid & 63, r32 = lane & 31, hi = lane >> 5;
  ATT_LAS char* V_lds = lds + OFF_V; ATT_LAS char* K_lds = lds + OFF_K; ATT_LAS char* KR_lds = lds + OFF_KR;
  ATT_LAS float* ws = (ATT_LAS float*)(lds + OFF_WS) + wid * 64; ATT_LAS float* li_l = ws; ATT_LAS float* al_l = ws + 32;
  ATT_LAS float* tab = (ATT_LAS float*)(lds + OFF_TAB);
  float m_reg = -1e30f, l_reg = 0; f32x16 o[4] = {}; bf16x8 qr[K8 ? 1 : NQR]; i32x8 q8[DQK / 64];
  if constexpr (K8 && Q8) {
    const unsigned char* Qb = (const unsigned char*)U.Q + (size_t)(wid * QBLK + r32) * U.ldq * 2 + hi * 32;
#pragma unroll
    for (int s = 0; s < DQK / 64; ++s) { const i32x4 lo = *reinterpret_cast<const i32x4*>(Qb + s * 64), hi_ = *reinterpret_cast<const i32x4*>(Qb + s * 64 + 16); q8[s] = __builtin_shufflevector(lo, hi_, 0, 1, 2, 3, 4, 5, 6, 7); }
  } else if constexpr (K8) {
    const bf16* Qw8 = U.Q + (long)(wid * QBLK + r32) * U.ldq + hi * 32;
#pragma unroll
    for (int s = 0; s < DQK / 64; ++s) { int w[8];
#pragma unroll
      for (int j = 0; j < 4; ++j) { const u32x4 x = *reinterpret_cast<const u32x4*>(Qw8 + s * 64 + j * 8);
        int lo = 0, hi_ = 0;
        lo = __builtin_amdgcn_cvt_pk_fp8_f32(__uint_as_float(x.x << 16), __uint_as_float(x.x & 0xffff0000u), lo, false); lo = __builtin_amdgcn_cvt_pk_fp8_f32(__uint_as_float(x.y << 16), __uint_as_float(x.y & 0xffff0000u), lo, true);
        hi_ = __builtin_amdgcn_cvt_pk_fp8_f32(__uint_as_float(x.z << 16), __uint_as_float(x.z & 0xffff0000u), hi_, false); hi_ = __builtin_amdgcn_cvt_pk_fp8_f32(__uint_as_float(x.w << 16), __uint_as_float(x.w & 0xffff0000u), hi_, true);
        w[2 * j] = lo; w[2 * j + 1] = hi_; }
      q8[s] = (i32x8){w[0], w[1], w[2], w[3], w[4], w[5], w[6], w[7]}; }
  } else {
    const bf16* Qw = U.Q + (long)(wid * QBLK + r32) * U.ldq + hi * 8;
#pragma unroll
    for (int d0 = 0; d0 < NQR; ++d0) qr[d0] = *reinterpret_cast<const bf16x8*>(Qw + d0 * 16);
  }
  const ATT_LAS char* Qrs = lds + OFF_OST + wid * 4096;
  const int vb0 = (int)(unsigned)(__UINTPTR_TYPE__)V_lds + v_rd_base(lane);
  const int kRow = tid >> 4, voK = kRow * U.ldkv + (((tid & 15) ^ (kRow & 7)) << 3);
  const int vkk = ((tid >> 7) << 3) + ((tid >> 2) & 7), vk = (vkk & ~0xC) | ((vkk & 4) << 1) | ((vkk & 8) >> 1), voV = vk * U.ldkv + ((tid >> 5) & 3) * 32 + (tid & 3) * 8;
  const int rRow = tid >> 3, voR = rRow * U.ldkr + (((tid & 7) ^ (rRow & 7)) << 3);
  const int voK8 = rRow * U.ldk8 + (((tid & 7) ^ ((rRow >> 1) & 7)) << 4);
  const int r8Row = (tid & 255) >> 2, voR8 = r8Row * 64 + (((tid & 3) ^ ((r8Row >> 2) & 3)) << 4);
  const unsigned wls = (unsigned)wid * 1024u;
  const int vKey = tid >> 3, voV8 = vKey * U.ldv8 + ((((tid & 7) ^ ((vKey & 3) | (((vKey >> 3) & 1) << 2)))) << 4);
  int vb8[4];
  { const int i16 = lane & 15, r_ = i16 >> 1, c_ = i16 & 1, gpar = (lane >> 4) & 1, key0 = 8 * (r_ >> 2) + 4 * hi + (r_ & 3);
#pragma unroll
    for (int d0 = 0; d0 < 4; ++d0) vb8[d0] = (int)(unsigned)(__UINTPTR_TYPE__)V_lds + key0 * 128 + (((2 * d0 + gpar) ^ r_) << 4) + 8 * c_; }
  int na_qrow = 0, na_rs = 0, na_lo = 0, na_tb = 0;
  if constexpr (MODE == 1) {
    for (int i = tid; i < 15 * 128; i += 512) { const int dr = i >> 7, x = (i & 127) - 48; tab[i] = (x >= 0 && x < 31) ? U.rpb[dr * 31 + x] * (1.0f / SCALE) : 0.f; }
    na_qrow = U.qrow0 + (wid >> 1);
    const int c = 32 * (wid & 1) + r32; int cs = c - 8; cs = cs < 0 ? 0 : (cs > 48 ? 48 : cs);
    na_rs = na_qrow - 4; na_rs = na_rs < 0 ? 0 : (na_rs > 24 ? 24 : na_rs);
    na_lo = cs - 4 * hi;
    na_tb = 63 - c + 4 * hi;
  }
  auto krow = [&](int j) -> long { return (j < U.n0) ? (long)U.base0 + 64 * j : (long)U.base1 + 64 * (j - U.n0); };
#define DMA16(g, l) __builtin_amdgcn_global_load_lds((const unsigned*)(g), (ATT_LAS unsigned*)(l), 16, 0, 0)
#define ISSUE_K(j, b) do { const long _k0 = krow(j); if constexpr (K8) { DMA16(U.K8 + _k0 * U.ldk8 + voK8, K_lds + (b) * SHM_K + wls); if constexpr (DQK == 192) DMA16(U.Kr8 + _k0 * 64 + voR8, KR_lds + (b) * SHM_KR + (wls & 3072u)); } else { const bf16* _kp = U.Kn + _k0 * U.ldkv; \
    DMA16(_kp + voK, K_lds + (b) * SHM_K + wls); DMA16(_kp + 32 * U.ldkv + voK, K_lds + (b) * SHM_K + wls + 8192); } \
    if constexpr (DQK == 192 && !K8) { const bf16* _rp = U.Kr + _k0 * U.ldkr; DMA16(_rp + voR, KR_lds + (b) * SHM_KR + wls); } } while (0)
#define ISSUE_V(j, b) do { const long _k0 = krow(j); if constexpr (K8) { DMA16(U.V8 + _k0 * U.ldv8 + voV8, V_lds + (b) * SHM_V + wls); } else { const bf16* _vp = U.V + _k0 * U.ldkv; \
    DMA16(_vp + voV, V_lds + (b) * SHM_V + wls); DMA16(_vp + 32 * U.ldkv + voV, V_lds + (b) * SHM_V + wls + 8192); } } while (0)
#define WAITNV() do { if constexpr (K8) WAITV(1); else WAITV(2); } while (0)
#define WAITV(n) asm volatile("s_waitcnt vmcnt(" #n ")" ::: "memory")
#define BAR() do { asm volatile("" ::: "memory"); __builtin_amdgcn_s_barrier(); asm volatile("" ::: "memory"); } while (0)
#define RESC(a) do { if (__any((a) < 1.f)) { if (hi == 0) al_l[r32] = (a); asm volatile("s_waitcnt lgkmcnt(0)" ::: "memory"); \
    asm volatile("s_nop 15\n\ts_nop 7" : "+v"(o[0]), "+v"(o[1]), "+v"(o[2]), "+v"(o[3]));        \
    _Pragma("unroll") for (int d = 0; d < 4; ++d) _Pragma("unroll") for (int r = 0; r < 16; ++r) o[d][r] *= al_l[crow(r, hi)]; } } while (0)
#define NAHOOK(P0, P1, j) do { if constexpr (MODE == 1) { if ((j) >= U.n0) { \
      const int _kr = U.krow0 + ((j) - U.n0); const bool _rv = (_kr >= na_rs) && (_kr < na_rs + 8); \
      int _dr = _kr - na_qrow + 7; _dr = _dr < 0 ? 0 : (_dr > 14 ? 14 : _dr); \
      const ATT_LAS float* _t = tab + _dr * 128 + na_tb; \
      _Pragma("unroll") for (int r = 0; r < 16; ++r) { const int kc0 = (r & 3) + 8 * (r >> 2); \
        const bool v0 = _rv && ((unsigned)(kc0 - na_lo) < 16u); const bool v1 = _rv && ((unsigned)(kc0 + 32 - na_lo) < 16u); \
        P0[r] = v0 ? P0[r] + _t[kc0] : -1e30f; P1[r] = v1 ? P1[r] + _t[kc0 + 32] : -1e30f; } } } } while (0)
  f32x16 pA0, pA1, pB0, pB1; float mnA = 0.f, mnB = 0.f, alA = 1.f, alB = 1.f; bf16x8 pa0, pa1, pa2, pa3; i32x8 P8; const int NT = U.NT;
  auto live = [&](int j) -> bool { if constexpr (MODE == 1) { if (j >= U.n0) { const int kr_ = U.krow0 + (j - U.n0); return (kr_ >= na_rs) && (kr_ < na_rs + 8); } } return true; };
#define QKT(P0, P1, KB, KRB) do { if constexpr (K8) qkt8<DQK>(P0, P1, KB, KRB, q8, r32, hi); else qkt<DQK>(P0, P1, KB, KRB, qr, Qrs, r32, hi); } while (0)
#define FINPV(PP0, PP1, ALP, VB) do { if constexpr (K8) { finishSM8(PP0, PP1, ALP, l_reg, P8); SBAR(); pv8(o, vb8, (VB) - vb0, P8); } else { finishSM(PP0, PP1, ALP, l_reg, pa0, pa1, pa2, pa3); SBAR(); pv_d0(o, VB, pa0, pa1, pa2, pa3); } } while (0)
#define TRBLK(X, D0, VBO) const u32x2 X##0 = tr8_read<0>(vb8[D0] + (VBO)), X##1 = tr8_read<2048>(vb8[D0] + (VBO)), X##2 = tr8_read<4096>(vb8[D0] + (VBO)), X##3 = tr8_read<6144>(vb8[D0] + (VBO))
#define TRVF(X) (i32x8){(int)(X##0).x, (int)(X##0).y, (int)(X##1).x, (int)(X##1).y, (int)(X##2).x, (int)(X##2).y, (int)(X##3).x, (int)(X##3).y}
#define FUSED_B(PS0, PS1, js, MNS, ALS, VBO) do { const int one = 0x7F7F7F7F; constexpr float C_ = SCALE * 1.4426950408889634f; \
    TRBLK(x_, 0, VBO); TRBLK(y_, 1, VBO); asm volatile("s_waitcnt lgkmcnt(4)" ::: "memory"); \
    { const i32x8 vf = TRVF(x_); ATT_MF2(o[0], P8, vf, PS0, PS1); } \
    NAHOOK(PS0, PS1, js); \
    float pmax_ = PS0[0]; \
    _Pragma("unroll") for (int r = 1; r < 16; ++r) pmax_ = fmaxf(pmax_, PS0[r]); \
    _Pragma("unroll") for (int r = 0; r < 16; ++r) pmax_ = fmaxf(pmax_, PS1[r]); \
    { auto rr = __builtin_amdgcn_permlane32_swap(__float_as_uint(pmax_), __float_as_uint(pmax_), false, false); pmax_ = fmaxf(__uint_as_float(rr[0]), __uint_as_float(rr[1])); } \
    if (__builtin_expect(__all(pmax_ - m_reg <= 3.f / SCALE), 1)) { MNS = m_reg; ALS = 1.f; } \
    else { MNS = fmaxf(m_reg, pmax_); ALS = __builtin_amdgcn_exp2f((m_reg - MNS) * C_); m_reg = MNS; } \
    const float mnC_ = -MNS * C_ + 4.f; \
    TRBLK(z_, 2, VBO); asm volatile("s_waitcnt lgkmcnt(4)" ::: "memory"); \
    { const i32x8 vf = TRVF(y_); ATT_MF2(o[1], P8, vf, PS0, PS1); } \
    _Pragma("unroll") for (int r = 0; r < 16; ++r) PS0[r] = fmaf(PS0[r], C_, mnC_); \
    _Pragma("unroll") for (int r = 0; r < 16; ++r) PS1[r] = fmaf(PS1[r], C_, mnC_); \
    TRBLK(u_, 3, VBO); asm volatile("s_waitcnt lgkmcnt(4)" ::: "memory"); \
    { const i32x8 vf = TRVF(z_); ATT_MF2(o[2], P8, vf, PS0, PS1); } \
    exp_rng<0, 4>(PS0); \
    asm volatile("s_waitcnt lgkmcnt(0)" ::: "memory"); \
    { const i32x8 vf = TRVF(u_); ATT_MF2(o[3], P8, vf, PS0, PS1); } \
    exp_rng<4, 16>(PS0); } while (0)
#define HALF_STEP(PS0, PS1, KB, KRB, js, MNS, ALS, PP0, PP1, ALP, VB, jp) do { const bool ls_ = live(js), lp_ = live(jp); bool fz_ = false; if constexpr (K8 && MODE == 0) fz_ = ls_ && lp_; \
    if (fz_) { if constexpr (K8 && MODE == 0) { SBAR(); fusedA<DQK>(PS0, PS1, KB, KRB, q8, r32, hi, PP0, PP1, ALP, l_reg, P8); FUSED_B(PS0, PS1, js, MNS, ALS, (VB) - vb0); } } \
    else { \
    if (ls_) { SBAR(); QKT(PS0, PS1, KB, KRB); } \
    if (lp_) { FINPV(PP0, PP1, ALP, VB); } \
    if (ls_) { NAHOOK(PS0, PS1, js); partialSM<DQK, K8>(PS0, PS1, m_reg, MNS, ALS); } else { ALS = 1.f; } } } while (0)
  WAITV(0);
  if (!pre) { ISSUE_K(0, 0); ISSUE_V(0, 0); ISSUE_K(1, 1);
    if constexpr (K8) { if constexpr (DQK == 192) WAITV(2); else WAITV(1); } else { if constexpr (DQK == 192) WAITV(3); else WAITV(2); } }
  asm volatile("s_waitcnt lgkmcnt(0)" ::: "memory"); BAR();
  QKT(pA0, pA1, K_lds, KR_lds); NAHOOK(pA0, pA1, 0); partialSM<DQK, K8>(pA0, pA1, m_reg, mnA, alA);
  ISSUE_V(1, 1);
  WAITNV(); BAR();
  for (int j = 1; j + 1 < NT; j += 2) {
    ISSUE_K(j + 1, 0);
    HALF_STEP(pB0, pB1, K_lds + SHM_K, KR_lds + SHM_KR, j, mnB, alB, pA0, pA1, alA, vb0, j - 1);
    BAR();
    ISSUE_V(j + 1, 0);
    RESC(alB);
    WAITNV(); BAR();
    ISSUE_K(j + 2, 1);
    HALF_STEP(pA0, pA1, K_lds, KR_lds, j + 1, mnA, alA, pB0, pB1, alB, vb0 + SHM_V, j);
    BAR();
    ISSUE_V(j + 2, 1);
    RESC(alA);
    WAITNV(); BAR();
  }
  HALF_STEP(pB0, pB1, K_lds + SHM_K, KR_lds + SHM_KR, NT - 1, mnB, alB, pA0, pA1, alA, vb0, NT - 2);
  RESC(alB);
  WAITV(0); BAR();
  if constexpr (K8) { if (has_next) {
      const int nK = rRow * N.ldk8 + (((tid & 7) ^ ((rRow >> 1) & 7)) << 4), nV = vKey * N.ldv8 + ((((tid & 7) ^ ((vKey & 3) | (((vKey >> 3) & 1) << 2)))) << 4);
      const long k0_ = (0 < N.n0) ? (long)N.base0 : (long)N.base1, k1_ = (1 < N.n0) ? (long)N.base0 + 64 : (long)N.base1 + 64 * (1 - N.n0);
      DMA16(N.K8 + k0_ * N.ldk8 + nK, K_lds + wls); if constexpr (DQK == 192) DMA16(N.Kr8 + k0_ * 64 + voR8, KR_lds + (wls & 3072u));
      DMA16(N.V8 + k0_ * N.ldv8 + nV, V_lds + wls);
      DMA16(N.K8 + k1_ * N.ldk8 + nK, K_lds + SHM_K + wls); if constexpr (DQK == 192) DMA16(N.Kr8 + k1_ * 64 + voR8, KR_lds + SHM_KR + (wls & 3072u)); } }
  if (live(NT - 1)) { FINPV(pB0, pB1, alB, vb0 + SHM_V); }
  int le_ = lane; asm volatile("" : "+v"(le_)); const int r32e = le_ & 31, hie = le_ >> 5;
  if (hie == 0) li_l[r32e] = l_reg; asm volatile("s_waitcnt lgkmcnt(0)" ::: "memory");
  float rli[16];
#pragma unroll
  for (int r = 0; r < 16; ++r) rli[r] = __builtin_amdgcn_rcpf(li_l[crow(r, hie)]) * YS;
  { ATT_LAS unsigned char* st = (ATT_LAS unsigned char*)(lds + OFF_OST) + wid * 4096;
#pragma unroll
    for (int r = 0; r < 16; ++r) { const int orow = crow(r, hie);
#pragma unroll
      for (int d0 = 0; d0 < 4; ++d0) { const int w = __builtin_amdgcn_cvt_pk_fp8_f32(o[d0][r] * rli[r], 0.f, 0, false); st[orow * 128 + d0 * 32 + r32e] = (unsigned char)w; } }
    asm volatile("s_waitcnt lgkmcnt(0)" ::: "memory");
    unsigned char* Ob = (unsigned char*)U.O + (size_t)(wid * QBLK) * U.ldo * 2 + (le_ & 7) * 16;
#pragma unroll
    for (int i = 0; i < 4; ++i) { const int row = (le_ >> 3) + 8 * i; const u32x4 w = *(const ATT_LAS u32x4*)(st + row * 128 + (le_ & 7) * 16);
      *(u32x4*)(Ob + (size_t)row * U.ldo * 2) = w; }
    asm volatile("s_waitcnt lgkmcnt(0)" ::: "memory"); }
  BAR();
#undef HALF_STEP
#undef FUSED_B
#undef TRBLK
#undef TRVF
#undef FINPV
#undef WAITNV
#undef QKT
#undef DMA16
#undef ISSUE_K
#undef ISSUE_V
#undef WAITV
#undef BAR
#undef RESC
#undef NAHOOK
}
}
constexpr int NB = 8, SEQ = 2048, CTXL = 256, D = 2048, TPB = SEQ + CTXL  , M = NB * TPB  ;
constexpr int DEPTH = 2;
constexpr int N_IN = 19008, NP = 19200  , LDP = 21248  , C_YA = 19200;
constexpr int C_MQ = 0, C_CKV = 3072, C_KR = 3584, C_NQ = 3648, C_NK = 5696, C_NV = 7744, C_GQ = 9792, C_GK = 11840, C_GV = 12352, C_GATE = 12864;
constexpr int KVR = 512, KVW = 4096, DFF = 5632, DFF2 = 11264, ADA = 12288;
constexpr float ALPHA = 1.4142135623730951f, ADA_EPS = 1e-6f, POST_EPS = 1e-5f, RMS_EPS = 1e-6f;
constexpr size_t MiB = 1u << 20;
constexpr size_t WS_CTL = 0, CTL_ZERO_BYTES = 64 * 1024;
constexpr size_t WS_MFIN = 1 * MiB, WS_MPART = 2 * MiB, WS_XCTX = 16 * MiB, WS_C = 32 * MiB, WS_KRR = 50 * MiB;
constexpr size_t WS_WIN = 53 * MiB, WS_WUKV = 128 * MiB, WS_WBR = 132 * MiB, WS_WOUT = 156 * MiB, WS_WUP = 164 * MiB, WS_WDN = 208 * MiB;
constexpr size_t WS_KV = 230 * MiB, WS_P = 374 * MiB, WS_KN8 = 1121 * MiB  , WS_END = 1157 * MiB;
constexpr size_t WS_KM8 = WS_KV  , WS_VM8 = WS_KV + 36 * MiB  , WS_VN8 = WS_KV + 72 * MiB  , WS_VG8 = WS_KV + 108 * MiB  ;
constexpr size_t WS_KG8 = WS_MPART;
constexpr size_t WS_ACC = WS_KV, WS_ACC8 = WS_KV + 72 * MiB  , WS_H2 = WS_KV + 72 * MiB, WS_FOUT = WS_KV;
constexpr size_t WS_YOUT = WS_P, WS_SBG = WS_P  , WS_SBV = WS_P + 16 * MiB  , WS_A = WS_P + 396 * MiB;
static_assert(WS_WIN + (size_t)NP * D * 2 <= WS_WUKV && WS_KV + (size_t)M * KVW * 2 <= WS_P && WS_P + (size_t)M * LDP * 2 <= WS_KN8 && WS_KN8 + (size_t)M * 2048 <= WS_END && WS_KG8 + (size_t)M * 512 <= WS_XCTX && WS_A + (size_t)M * DFF * 2 <= WS_END && (size_t)M * DFF2 * 2 <= 396 * MiB, "ws map");
constexpr int CW_BAR = 4096;
constexpr int RING_BYTES = 131072, LDSCTL_OFF = RING_BYTES, MISC_OFF = LDSCTL_OFF + 320, LDS_BYTES = 147456;
constexpr int NWAVES = 8;

#define GAS __attribute__((address_space(1)))
#define LAS __attribute__((address_space(3)))
typedef unsigned short bf16;
typedef unsigned v4u __attribute__((ext_vector_type(4)));
typedef unsigned v2u __attribute__((ext_vector_type(2)));
typedef float f32x4 __attribute__((ext_vector_type(4)));
#define LDS_WAIT() asm volatile("s_waitcnt lgkmcnt(0)" ::: "memory")
__device__ __forceinline__ unsigned f2bf(float f) { unsigned u = __builtin_bit_cast(unsigned, f); return (u + 0x7fffu + ((u >> 16) & 1u)) >> 16; }
__device__ __forceinline__ unsigned pk2(float lo, float hi) { return f2bf(lo) | (f2bf(hi) << 16); }
__device__ __forceinline__ float bf2f(unsigned short b) { return __uint_as_float(((unsigned)b) << 16); }
__device__ __forceinline__ float wave_sum(float v) {
#pragma unroll
    for (int o = 1; o < 64; o <<= 1) v += __shfl_xor(v, o);
    return v;
}

#define XB_TMO      128
#define XB_XCNT(j)  (256  + 64 * (j))
#define XB_XSUB(j)  (1280 + 64 * (j))
#define XB_XGEN(j)  (2304 + 64 * (j))
#define XB_TOP      3328
#define XB_TOPGEN   3392
#define XCD_BAR_WORDS 3456
#define XB_SPIN_CAP (1u << 18)
__device__ __forceinline__ unsigned xb_ld(unsigned* p)              { return __hip_atomic_load(p, __ATOMIC_RELAXED, __HIP_MEMORY_SCOPE_AGENT); }
__device__ __forceinline__ unsigned xb_add(unsigned* p, unsigned v) { return __hip_atomic_fetch_add(p, v, __ATOMIC_RELAXED, __HIP_MEMORY_SCOPE_AGENT); }
__device__ __forceinline__ unsigned xb_xcc_id() { return (unsigned)__builtin_amdgcn_s_getreg((3 << 11) | 20) & 0xFu; }
#define XB_SPIN(cond, bar) do { unsigned _sp = 0; while (cond) { __builtin_amdgcn_s_sleep(1); \
    if ((++_sp & 255u) == 0u) { if (xb_ld(&(bar)[XB_TMO])) break; if (_sp > XB_SPIN_CAP) { atomicAdd(&(bar)[XB_TMO], 1u); break; } } } } while (0)
struct XcdBarrier { unsigned* bar; unsigned x; volatile LAS unsigned* st; };
__device__ __forceinline__ XcdBarrier xcd_barrier_post(unsigned* bar, volatile LAS unsigned* st) {
    XcdBarrier b; b.bar = bar; b.x = xb_xcc_id(); b.st = st;
    if (threadIdx.x == 0) (void)xb_add(&bar[XB_XCNT(b.x)], 1u);
    return b;
}
__device__ __forceinline__ void xcd_barrier_complete(unsigned* bar, unsigned x, unsigned& nloc, unsigned& nx) {
    const unsigned G = gridDim.x * gridDim.y * gridDim.z;
    unsigned sum, cnt, mine, sp = 0u;
    for (;;) {
        sum = 0u; cnt = 0u; mine = 0u;
#pragma unroll
        for (unsigned j = 0; j < 16; ++j) { const unsigned c = xb_ld(&bar[XB_XCNT(j)]); sum += c; cnt += (c > 0u) ? 1u : 0u; mine = (j == x) ? c : mine; }
        if (sum == G) break;
        __builtin_amdgcn_s_sleep(1);
        if ((++sp & 255u) == 0u) { if (xb_ld(&bar[XB_TMO])) break; if (sp > XB_SPIN_CAP) { atomicAdd(&bar[XB_TMO], 1u); break; } }
    }
    nloc = mine > 0u ? mine : 1u; nx = cnt > 0u ? cnt : 1u;
}
__device__ __forceinline__ void xcd_barrier(const XcdBarrier& b) {
    asm volatile("s_waitcnt vmcnt(0)" ::: "memory");
    __syncthreads();
    if (threadIdx.x == 0) {
        unsigned* bar = b.bar;
        __builtin_amdgcn_s_waitcnt(0);
        unsigned nloc = b.st[0], nx = b.st[1];
        if (nloc == 0u) { xcd_barrier_complete(bar, b.x, nloc, nx); b.st[0] = nloc; b.st[1] = nx; }
        const unsigned old = xb_add(&bar[XB_XSUB(b.x)], 1u);
        const unsigned gen = old / nloc;
        if (old + 1u == (gen + 1u) * nloc) {
            __builtin_amdgcn_fence(__ATOMIC_RELEASE, "agent");
            asm volatile("s_waitcnt vmcnt(0)" ::: "memory");
            const unsigned og = xb_add(&bar[XB_TOP], 1u);
            const unsigned tg = og / nx;
            if (og + 1u == (tg + 1u) * nx) xb_add(&bar[XB_TOPGEN], 1u);
            else XB_SPIN(xb_ld(&bar[XB_TOPGEN]) == tg, bar);
            __builtin_amdgcn_fence(__ATOMIC_ACQUIRE, "agent");
            xb_add(&bar[XB_XGEN(b.x)], 1u);
            asm volatile("s_waitcnt vmcnt(0)" ::: "memory");
        } else {
            XB_SPIN(xb_ld(&bar[XB_XGEN(b.x)]) == gen, bar);
            __builtin_amdgcn_fence(__ATOMIC_ACQUIRE, "agent");
            asm volatile("s_waitcnt vmcnt(0)" ::: "memory");
        }
    }
    __syncthreads();
}

struct Args { const float* in[22]; float* out; unsigned char* ws; };
enum { I_X = 0, I_C, I_CTX, I_CCTX, I_WADA, I_BADA, I_WIN, I_KVNORM, I_WUKV, I_QNORM, I_KNORM, I_RPB, I_WBR, I_WOUT, I_LNAG, I_LNAB, I_WUP, I_CONVW, I_CONVB, I_WDOWN, I_LNFG, I_LNFB };
struct Frame { LAS unsigned char* lds; int tid, lane, wave, G, vcu; };
constexpr int PTAB_OFF = LDSCTL_OFF + 512;
__device__ __forceinline__ unsigned long long ptab_get(const Frame& F, int i) {
    volatile LAS unsigned* t = (volatile LAS unsigned*)(F.lds + PTAB_OFF) + 2 * i;
    const unsigned lo = __builtin_amdgcn_readfirstlane(t[0]), hi = __builtin_amdgcn_readfirstlane(t[1]);
    return ((unsigned long long)hi << 32) | lo;
}
__device__ __forceinline__ const float* in_ptr(const Frame& F, int i) { return (const float*)(const GAS float*)ptab_get(F, i); }
__device__ __forceinline__ float* out_ptr(const Frame& F) { return (float*)(GAS float*)ptab_get(F, 22); }
__device__ __forceinline__ unsigned char* ws_ptr(const Frame& F) { return (unsigned char*)(GAS unsigned char*)ptab_get(F, 23); }
__device__ __forceinline__ int opq_v(int x) { asm volatile("" : "+v"(x)); return x; }
__device__ __forceinline__ int opq_s(int x) { asm volatile("" : "+s"(x)); return x; }
__device__ __forceinline__ LAS unsigned char* opq_l(LAS unsigned char* p) { unsigned v = (unsigned)(__UINTPTR_TYPE__)p; asm volatile("" : "+s"(v)); return (LAS unsigned char*)(__UINTPTR_TYPE__)v; }
__device__ __forceinline__ Frame fresh(const Frame& F0) { Frame F; F.lds = opq_l(F0.lds); F.tid = opq_v(F0.tid); F.lane = F.tid & 63; F.wave = __builtin_amdgcn_readfirstlane(F.tid >> 6); F.G = opq_s(F0.G); F.vcu = opq_s(F0.vcu); return F; }

template <bool PAIR = false>
__device__ __forceinline__ void transpose_item(const float* W, int K, int N, bf16* WT, LAS float* scr, int item, int lane) {
    const int nblk = N / 32, kb = item / nblk, nb = item % nblk, k0 = 64 * kb, n0 = 32 * nb;
    int d0 = n0; if (PAIR) { const int h = N / 2, cc = n0 >= h ? n0 - h : n0; d0 = (cc >> 7) * 256 + (n0 >= h ? 128 : 0) + (cc & 127); }
    float t[32];
#pragma unroll
    for (int i = 0; i < 32; ++i) { const int kk = 2 * i + (lane >> 5); t[i] = __builtin_nontemporal_load(W + (size_t)(k0 + kk) * N + n0 + (lane & 31)); }
#pragma unroll
    for (int i = 0; i < 32; ++i) { const int kk = 2 * i + (lane >> 5); scr[kk * 33 + (lane & 31)] = t[i]; }
    LDS_WAIT(); asm volatile("" ::: "memory");
    const int c = lane & 7;
#pragma unroll
    for (int j = 0; j < 4; ++j) { const int n = (lane >> 3) + 8 * j; const LAS float* s = scr + (8 * c) * 33 + n;
        v4u o; o.x = pk2(s[0 * 33], s[1 * 33]); o.y = pk2(s[2 * 33], s[3 * 33]); o.z = pk2(s[4 * 33], s[5 * 33]); o.w = pk2(s[6 * 33], s[7 * 33]);
        *(v4u*)(WT + (size_t)(d0 + n) * K + k0 + 8 * c) = o; }
    LDS_WAIT(); asm volatile("" ::: "memory");
}
constexpr float W8_SCALE = 64.0f, WB_SCALE = 128.0f, ACC_SCALE = 16.0f, WKV_SCALE = 32.0f;
__device__ __forceinline__ unsigned pk4_fp8(float a, float b, float c, float d) { int w = 0; w = __builtin_amdgcn_cvt_pk_fp8_f32(a, b, w, false); w = __builtin_amdgcn_cvt_pk_fp8_f32(c, d, w, true); return (unsigned)w; }
template <bool REMAP = false>
__device__ __forceinline__ void transpose_item_fp8(const float* W, int K, int N, unsigned char* WT, LAS float* scr, int item, int lane, float wscale) {
    const int nblk = N / 32, kb = item / nblk, nb = item % nblk, k0 = 64 * kb, n0 = 32 * nb;
    int d0 = n0; if (REMAP) { const int g = (n0 >> 5) & 7; d0 = (n0 & ~255) + (((g & 1) << 2) + (g >> 1)) * 32; }
    float t[32];
#pragma unroll
    for (int i = 0; i < 32; ++i) { const int kk = 2 * i + (lane >> 5); t[i] = __builtin_nontemporal_load(W + (size_t)(k0 + kk) * N + n0 + (lane & 31)); }
#pragma unroll
    for (int i = 0; i < 32; ++i) { const int kk = 2 * i + (lane >> 5); scr[kk * 33 + (lane & 31)] = t[i] * wscale; }
    LDS_WAIT(); asm volatile("" ::: "memory");
    const int c = lane & 7;
#pragma unroll
    for (int j = 0; j < 4; ++j) { const int n = (lane >> 3) + 8 * j; const LAS float* s = scr + (8 * c) * 33 + n;
        v2u o; o.x = pk4_fp8(s[0 * 33], s[1 * 33], s[2 * 33], s[3 * 33]); o.y = pk4_fp8(s[4 * 33], s[5 * 33], s[6 * 33], s[7 * 33]);
        *(v2u*)(WT + (size_t)(d0 + n) * K + k0 + 8 * c) = o; }
    LDS_WAIT(); asm volatile("" ::: "memory");
}
__device__ __forceinline__ void convert_weights(const Frame& F0, int l) {
    const Frame F = fresh(F0);
    LAS float* scr = (LAS float*)(F.lds + F.wave * 16384);
    const int gw = F.vcu * NWAVES + F.wave, NGW = F.G * NWAVES;
    constexpr int I_IN = (D / 64) * (N_IN / 32), I_UKV = (KVR / 64) * (KVW / 32), I_BR = (D / 64) * (D / 32), I_OUT = I_BR, I_UP = (D / 64) * (DFF2 / 32), I_DN = (DFF / 64) * (D / 32);
    constexpr int NITEMS = I_IN + I_UKV + 3 * I_BR + I_OUT + I_UP + I_DN;
    unsigned char* ws = ws_ptr(F);
    const float* w_in = in_ptr(F, I_WIN); const float* w_ukv = in_ptr(F, I_WUKV); const float* w_br = in_ptr(F, I_WBR); const float* w_out = in_ptr(F, I_WOUT); const float* w_up = in_ptr(F, I_WUP); const float* w_dn = in_ptr(F, I_WDOWN);
    for (int it = gw; it < NITEMS; it += NGW) {
        int r = it;
        if (r < I_IN) { transpose_item_fp8<true>(w_in + (size_t)l * D * N_IN, D, N_IN, (unsigned char*)(ws + WS_WIN), scr, r, F.lane, W8_SCALE); continue; } r -= I_IN;
        if (r < I_UKV) { transpose_item_fp8(w_ukv + (size_t)l * KVR * KVW, KVR, KVW, (unsigned char*)(ws + WS_WUKV), scr, r, F.lane, WKV_SCALE); continue; } r -= I_UKV;
        if (r < 3 * I_BR) { const int i = r / I_BR; transpose_item_fp8(w_br + (size_t)(l * 3 + i) * D * D, D, D, (unsigned char*)(ws + WS_WBR) + (size_t)i * D * D, scr, r % I_BR, F.lane, WB_SCALE); continue; } r -= 3 * I_BR;
        if (r < I_OUT) { transpose_item_fp8(w_out + (size_t)l * D * D, D, D, (unsigned char*)(ws + WS_WOUT), scr, r, F.lane, WB_SCALE); continue; } r -= I_OUT;
        if (r < I_UP) { transpose_item<true>(w_up + (size_t)l * D * DFF2, D, DFF2, (bf16*)(ws + WS_WUP), scr, r, F.lane); continue; } r -= I_UP;
        transpose_item(w_dn + (size_t)l * DFF * D, DFF, D, (bf16*)(ws + WS_WDN), scr, r, F.lane);
    }
    { constexpr int per = 32 * D / 16, nz = (NP - N_IN) / 32 * per;
      for (int i = F.vcu * 512 + F.tid; i < nz; i += F.G * 512) { const int g = (N_IN % 256) / 32 + i / per, gp = ((g & 1) << 2) + (g >> 1);
          ((v4u*)(ws + WS_WIN + (size_t)((N_IN & ~255) + gp * 32) * D))[i % per] = (v4u){0u, 0u, 0u, 0u}; } }
}
__device__ __forceinline__ void adaln_partial(const Frame& F0) {
    const Frame F = fresh(F0);
    LAS float* sc = (LAS float*)F.lds;
    float* MPART = (float*)(ws_ptr(F) + WS_MPART);
    const float* cin = in_ptr(F, I_C); const float* cctx = in_ptr(F, I_CCTX); const float* wada = in_ptr(F, I_WADA);
    for (int item = F.vcu; item < 768; item += F.G) {
        const int l = item / 384, rem = item % 384, chunk = rem >> 4, s = rem & 15;
        __syncthreads();
        for (int idx = F.tid; idx < 9 * 128; idx += 512) { const int bi = idx >> 7, k = idx & 127; const float v = bi < 8 ? cin[bi * D + s * 128 + k] : cctx[s * 128 + k]; sc[idx] = v / (1.0f + expf(-v)); }
        __syncthreads();
        const int j = chunk * 512 + F.tid;
        const float* W = wada + ((size_t)l * D + s * 128) * ADA + j;
        float acc[9];
#pragma unroll
        for (int bi = 0; bi < 9; ++bi) acc[bi] = 0.f;
        for (int k = 0; k < 128; k += 32) {
            float w[32];
#pragma unroll
            for (int kk = 0; kk < 32; ++kk) w[kk] = __builtin_nontemporal_load(W + (size_t)(k + kk) * ADA);
#pragma unroll
            for (int kk = 0; kk < 32; ++kk)
#pragma unroll
                for (int bi = 0; bi < 9; ++bi) acc[bi] = fmaf(sc[bi * 128 + k + kk], w[kk], acc[bi]);
        }
#pragma unroll
        for (int bi = 0; bi < 9; ++bi) MPART[((size_t)(l * 16 + s) * 9 + bi) * ADA + j] = acc[bi];
    }
    __syncthreads();
}
__device__ __forceinline__ void adaln_final(const Frame& F0) {
    const Frame F = fresh(F0);
    unsigned char* ws = ws_ptr(F); const float* bada = in_ptr(F, I_BADA);
    const float* MPART = (const float*)(ws + WS_MPART); float* MFIN = (float*)(ws + WS_MFIN);
    for (int idx = F.vcu * 512 + F.tid; idx < DEPTH * 9 * ADA; idx += F.G * 512) {
        const int l = idx / (9 * ADA), rem = idx % (9 * ADA), bi = rem / ADA, j = rem % ADA;
        float s = bada[l * ADA + j];
#pragma unroll
        for (int k = 0; k < 16; ++k) s += MPART[((size_t)(l * 16 + k) * 9 + bi) * ADA + j];
        MFIN[idx] = s;
    }
}

__device__ __forceinline__ void ln_inplace(f32x4 (&v)[8], float eps) {
    float s = 0.f;
#pragma unroll
    for (int j = 0; j < 8; ++j) s += (v[j].x + v[j].y) + (v[j].z + v[j].w);
    const float mean = wave_sum(s) * (1.f / D); float s2 = 0.f;
#pragma unroll
    for (int j = 0; j < 8; ++j) { v[j] = v[j] - mean; s2 += (v[j].x * v[j].x + v[j].y * v[j].y) + (v[j].z * v[j].z + v[j].w * v[j].w); }
    const float rstd = 1.f / sqrtf(wave_sum(s2) * (1.f / D) + eps);
#pragma unroll
    for (int j = 0; j < 8; ++j) v[j] = v[j] * rstd;
}
template <int KIND>
__device__ __forceinline__ void row_phase(const Frame& F0, int l, bool poison) {
    const Frame F = fresh(F0);
    unsigned char* ws = ws_ptr(F); float* outp = out_ptr(F); const float* xin = in_ptr(F, I_X); const float* ctxin = in_ptr(F, I_CTX);
    const float* lng = in_ptr(F, KIND == 1 ? I_LNAG : I_LNFG) + (size_t)l * D; const float* lnb = in_ptr(F, KIND == 1 ? I_LNAB : I_LNFB) + (size_t)l * D;
    const float* MFIN = (const float*)(ws + WS_MFIN);
    const bool last = (l == DEPTH - 1);
    const bool want_h = !(KIND == 2 && last);
    const int lm = (KIND == 2) ? l + 1 : l;
    LAS f32x4* LG = (LAS f32x4*)F.lds; LAS f32x4* LB = LG + 512; LAS f32x4* SETS = LG + 1024;
    const bool from_input = (KIND == 0) || (KIND == 1 && l == 0);
    for (int chunk = F.vcu; chunk < M / 72; chunk += F.G) {
        const int row_a = chunk * 72, row_b = row_a + 71;
        const int bA = row_a / TPB, bB = row_b / TPB; const int biA = (row_a - bA * TPB >= SEQ) ? 8 : bA, biB = (row_b - bB * TPB >= SEQ) ? 8 : bB;
        __syncthreads();
        { const int t = F.tid;
          if (KIND != 0) { LG[t] = ((const f32x4*)lng)[t]; LB[t] = ((const f32x4*)lnb)[t]; }
#pragma unroll
          for (int s_ = 0; s_ < 2; ++s_) { const int bi = s_ ? biB : biA;
              if (KIND != 0) SETS[s_ * 1536 + t] = ((const f32x4*)(MFIN + ((size_t)(l * 9 + bi) * 6 + (KIND == 1 ? 2 : 5)) * D))[t];
              if (want_h) { const float* sh = MFIN + ((size_t)(lm * 9 + bi) * 6 + (KIND == 1 ? 3 : 0)) * D; SETS[s_ * 1536 + 512 + t] = ((const f32x4*)sh)[t]; SETS[s_ * 1536 + 1024 + t] = ((const f32x4*)(sh + D))[t]; } } }
        __syncthreads();
        const int r0 = row_a + F.wave * 9;
        f32x4 xa[8], xb[8]; v2u ya[8], yb[8];
#define ROW_INFO(r, b_, i_, isctx_, skip_) const int b_ = (r) / TPB, i_ = (r) - b_ * TPB; const bool isctx_ = i_ >= SEQ; const bool skip_ = (KIND != 0 && last && isctx_)
#define ROW_XPTRS(b_, i_, isctx_, xsrc_, xdst_) float* xdst_ = isctx_ ? (float*)(ws + WS_XCTX) + (size_t)(b_ * CTXL + i_ - SEQ) * D : outp + (size_t)(b_ * SEQ + i_) * D; \
        const float* xsrc_ = from_input ? (isctx_ ? ctxin + (size_t)(b_ * CTXL + i_ - SEQ) * D : xin + (size_t)(b_ * SEQ + i_) * D) : xdst_
#define ROW_LOAD(r, X, Y) do { ROW_INFO(r, b_, i_, c_, sk_); if (!sk_) { ROW_XPTRS(b_, i_, c_, xs_, xd_); (void)xd_; \
        _Pragma("unroll") for (int j = 0; j < 8; ++j) X[j] = __builtin_nontemporal_load((const f32x4*)xs_ + F.lane + 64 * j); \
        if (KIND != 0) { const bf16* y_ = (const bf16*)(ws + (KIND == 1 ? WS_YOUT : WS_FOUT)) + (size_t)(r) * D; _Pragma("unroll") for (int j = 0; j < 8; ++j) Y[j] = __builtin_nontemporal_load((const v2u*)y_ + F.lane + 64 * j); } } } while (0)
#define ROW_PROC(r, X, Y) do { ROW_INFO(r, b_, i_, c_, sk_); if (!sk_) { ROW_XPTRS(b_, i_, c_, xs_, xd_); (void)xs_; const int bi_ = c_ ? 8 : b_; LAS f32x4* ST = SETS + (bi_ == biA ? 0 : 1536); \
        if (KIND != 0) { \
            _Pragma("unroll") for (int j = 0; j < 8; ++j) { const f32x4 yy = (f32x4){pg8::bf_lo(Y[j].x), pg8::bf_hi(Y[j].x), pg8::bf_lo(Y[j].y), pg8::bf_hi(Y[j].y)}; X[j] = X[j] * ALPHA + ST[F.lane + 64 * j] * yy; } \
            ln_inplace(X, POST_EPS); \
            _Pragma("unroll") for (int j = 0; j < 8; ++j) X[j] = X[j] * LG[F.lane + 64 * j] + LB[F.lane + 64 * j]; \
            if (poison) { _Pragma("unroll") for (int j = 0; j < 8; ++j) X[j] = X[j] * __builtin_nanf(""); } \
            _Pragma("unroll") for (int j = 0; j < 8; ++j) __builtin_nontemporal_store(X[j], (f32x4*)xd_ + F.lane + 64 * j); } \
        if (want_h) { ln_inplace(X, ADA_EPS); \
            bf16* h_ = (KIND == 1) ? (bf16*)(ws + WS_H2) + (size_t)(r) * D : (bf16*)(ws + WS_P) + (size_t)(r) * LDP + C_YA; \
            _Pragma("unroll") for (int j = 0; j < 8; ++j) { const f32x4 o_ = X[j] * (ST[1024 + F.lane + 64 * j] + 1.0f) + ST[512 + F.lane + 64 * j]; \
                if (KIND == 1) { v2u w_; w_.x = pk2(o_.x, o_.y); w_.y = pk2(o_.z, o_.w); ((v2u*)h_)[F.lane + 64 * j] = w_; } \
                else ((unsigned*)h_)[F.lane + 64 * j] = pk4_fp8(o_.x, o_.y, o_.z, o_.w); } } } } while (0)
        ROW_LOAD(r0, xa, ya);
#pragma unroll 1
        for (int k = 0; k < 8; k += 2) {
            ROW_LOAD(r0 + k + 1, xb, yb);
            ROW_PROC(r0 + k, xa, ya);
            ROW_LOAD(r0 + k + 2, xa, ya);
            ROW_PROC(r0 + k + 1, xb, yb);
        }
        ROW_PROC(r0 + 8, xa, ya);
#undef ROW_INFO
#undef ROW_XPTRS
#undef ROW_LOAD
#undef ROW_PROC
    }
    __syncthreads();
}

__device__ __forceinline__ void unpack8(const v4u x, float (&f)[8]) { f[0] = pg8::bf_lo(x.x); f[1] = pg8::bf_hi(x.x); f[2] = pg8::bf_lo(x.y); f[3] = pg8::bf_hi(x.y); f[4] = pg8::bf_lo(x.z); f[5] = pg8::bf_hi(x.z); f[6] = pg8::bf_lo(x.w); f[7] = pg8::bf_hi(x.w); }
__device__ __forceinline__ v4u pack8(const float (&f)[8]) { v4u o; o.x = pk2(f[0], f[1]); o.y = pk2(f[2], f[3]); o.z = pk2(f[4], f[5]); o.w = pk2(f[6], f[7]); return o; }
__device__ __forceinline__ void prep_phase(const Frame& F0, int l) {
    const Frame F = fresh(F0);
    const int gw = F.vcu * NWAVES + F.wave, NGW = F.G * NWAVES, lane = F.lane;
    unsigned char* ws = ws_ptr(F);
    bf16* P = (bf16*)(ws + WS_P); bf16* CB = (bf16*)(ws + WS_C); bf16* KRR = (bf16*)(ws + WS_KRR); unsigned char* KG8 = ws + WS_KG8;
    const float* kvn = in_ptr(F, I_KVNORM) + (size_t)l * KVR; const float* qn = in_ptr(F, I_QNORM) + (size_t)l * 128; const float* kn = in_ptr(F, I_KNORM) + (size_t)l * 128;
    const bool last = (l == DEPTH - 1);
    LAS float* TMc = (LAS float*)F.lds; LAS float* TMs = TMc + 65 * 16; LAS float* TGc = TMs + 65 * 16; LAS float* TGs = TGc + 65 * 32;
    __syncthreads();
    for (int idx = F.tid; idx < 65 * 16; idx += 512) { const int pos = idx >> 4, i = idx & 15; float sn = 0.f, cs = 1.f; if (pos < 64) sincosf((float)pos * exp2f(-(float)i * (13.287712379549449f / 16.0f)), &sn, &cs); TMc[idx] = cs; TMs[idx] = sn; }
    for (int idx = F.tid; idx < 65 * 32; idx += 512) { const int pos = idx >> 5, i = idx & 31; float sn = 0.f, cs = 1.f; if (pos < 64) sincosf((float)pos * exp2f(-(float)i * (13.287712379549449f / 32.0f)), &sn, &cs); TGc[idx] = cs; TGs[idx] = sn; }
    __syncthreads();
    const int l8 = lane & 7, l16 = lane & 15;
    float g8[8], qg[8], kg[8];
#pragma unroll
    for (int e = 0; e < 8; ++e) { g8[e] = kvn[lane * 8 + e]; qg[e] = qn[l16 * 8 + e]; kg[e] = kn[l16 * 8 + e]; }
    const bool m_col = (l8 >> 2) & 1, m_second = (l8 >> 1) & 1; const int m_i0 = 8 * (l8 & 1);
    const bool g_col = (l16 >> 3) & 1, g_second = (l16 >> 2) & 1; const int g_i0 = 8 * (l16 & 3);
    for (int r = gw; r < M; r += NGW) {
        const int b = r / TPB, i = r - b * TPB; const bool isctx = i >= SEQ;
        bf16* prow = P + (size_t)r * LDP;
        const int posr = isctx ? 64 : (i >> 6), posc = isctx ? 64 : (i & 63);
        { float f[8]; unpack8(*(const v4u*)(prow + C_CKV + lane * 8), f);
          float ss = 0.f;
#pragma unroll
          for (int e = 0; e < 8; ++e) ss += f[e] * f[e];
          const float rr = 1.f / sqrtf(wave_sum(ss) * (1.f / KVR) + RMS_EPS);
#pragma unroll
          for (int e = 0; e < 8; ++e) f[e] = f[e] * rr * g8[e];
          v2u w; w.x = pk4_fp8(f[0], f[1], f[2], f[3]); w.y = pk4_fp8(f[4], f[5], f[6], f[7]); *(v2u*)((unsigned char*)CB + (size_t)r * KVR + lane * 8) = w; }
        float mc[8], ms[8];
        { const int tb = (m_col ? posc : posr) * 16 + m_i0;
          const f32x4 c0 = *(const LAS f32x4*)(TMc + tb), c1 = *(const LAS f32x4*)(TMc + tb + 4), s0 = *(const LAS f32x4*)(TMs + tb), s1 = *(const LAS f32x4*)(TMs + tb + 4);
          mc[0] = c0.x; mc[1] = c0.y; mc[2] = c0.z; mc[3] = c0.w; mc[4] = c1.x; mc[5] = c1.y; mc[6] = c1.z; mc[7] = c1.w;
          ms[0] = s0.x; ms[1] = s0.y; ms[2] = s0.z; ms[3] = s0.w; ms[4] = s1.x; ms[5] = s1.y; ms[6] = s1.z; ms[7] = s1.w; }
#pragma unroll
        for (int p = 0; p < 3; ++p) {
            const bool act = (p == 0) ? (lane < 8) : !isctx;
            const bf16* src = (p == 0) ? prow + C_KR + l8 * 8 : prow + C_MQ + ((p - 1) * 8 + (lane >> 3)) * 192 + 128 + l8 * 8;
            bf16* dst = (p == 0) ? KRR + (size_t)r * 64 + l8 * 8 : (bf16*)src;
            float f[8], o[8]; v4u x = (v4u){0u, 0u, 0u, 0u}; if (act) x = *(const v4u*)src; unpack8(x, f);
#pragma unroll
            for (int e = 0; e < 8; ++e) { const float xp = __shfl_xor(f[e], 2); o[e] = m_second ? (xp * ms[e] + f[e] * mc[e]) : (f[e] * mc[e] - xp * ms[e]); }
            if (act) { if (p == 0) { v2u w; w.x = pk4_fp8(o[0], o[1], o[2], o[3]); w.y = pk4_fp8(o[4], o[5], o[6], o[7]); *(v2u*)((unsigned char*)KRR + (size_t)r * 64 + l8 * 8) = w; } else *(v4u*)dst = pack8(o); }
        }
        float gc[8], gs[8];
        { const int tb = (g_col ? posc : posr) * 32 + g_i0;
          const f32x4 c0 = *(const LAS f32x4*)(TGc + tb), c1 = *(const LAS f32x4*)(TGc + tb + 4), s0 = *(const LAS f32x4*)(TGs + tb), s1 = *(const LAS f32x4*)(TGs + tb + 4);
          gc[0] = c0.x; gc[1] = c0.y; gc[2] = c0.z; gc[3] = c0.w; gc[4] = c1.x; gc[5] = c1.y; gc[6] = c1.z; gc[7] = c1.w;
          gs[0] = s0.x; gs[1] = s0.y; gs[2] = s0.z; gs[3] = s0.w; gs[4] = s1.x; gs[5] = s1.y; gs[6] = s1.z; gs[7] = s1.w; }
        const int p0 = (last && isctx) ? 4 : 0;
        for (int p = p0; p < 5; ++p) {
            const bool isk = (p == 4);
            bf16* q = prow + (isk ? C_GK : C_GQ + p * 512) + (lane >> 4) * 128 + l16 * 8;
            float f[8], o[8]; unpack8(*(const v4u*)q, f);
            float ss = 0.f;
#pragma unroll
            for (int e = 0; e < 8; ++e) ss += f[e] * f[e];
            ss += __shfl_xor(ss, 1); ss += __shfl_xor(ss, 2); ss += __shfl_xor(ss, 4); ss += __shfl_xor(ss, 8);
            const float rr = 1.f / sqrtf(ss * (1.f / 128.f) + RMS_EPS);
#pragma unroll
            for (int e = 0; e < 8; ++e) f[e] = f[e] * rr * (isk ? kg[e] : qg[e]);
#pragma unroll
            for (int e = 0; e < 8; ++e) { const float xp = __shfl_xor(f[e], 4); o[e] = g_second ? (xp * gs[e] + f[e] * gc[e]) : (f[e] * gc[e] - xp * gs[e]); }
            if (isk) { v2u w; w.x = pk4_fp8(o[0], o[1], o[2], o[3]); w.y = pk4_fp8(o[4], o[5], o[6], o[7]); *(v2u*)(KG8 + (size_t)r * 512 + (lane >> 4) * 128 + l16 * 8) = w; }
            else { v2u w; w.x = pk4_fp8(o[0], o[1], o[2], o[3]); w.y = pk4_fp8(o[4], o[5], o[6], o[7]); *(v2u*)((unsigned char*)(q - l16 * 8) + l16 * 8) = w; }
        }
    }
    __syncthreads();
}

__device__ __forceinline__ void conv_fixup(const Frame& F0, int l) {
    const Frame F = fresh(F0);
    unsigned char* ws = ws_ptr(F);
    const bf16* SBG = (const bf16*)(ws + WS_SBG); const bf16* SBV = (const bf16*)(ws + WS_SBV); bf16* A = (bf16*)(ws + WS_A);
    const float* cw = in_ptr(F, I_CONVW) + (size_t)l * 3 * DFF; const float* cb = in_ptr(F, I_CONVB) + (size_t)l * DFF;
    const bool last = (l == DEPTH - 1);
    constexpr int CH = DFF / 8, NBLK = M / 64;
    const int total = NBLK * 2 * CH;
    const v4u Z = (v4u){0u, 0u, 0u, 0u};
    for (int idx = F.vcu * 512 + F.tid; idx < total; idx += F.G * 512) {
        const int ch = idx % CH, bs = idx / CH, s_ = bs & 1, B = bs >> 1, col = ch * 8;
        const int r = B * 64 + (s_ ? 63 : 0), b = r / TPB, i = r - b * TPB;
        if (last && i >= SEQ) continue;
        const bool hasl = (i != 0) && (i != SEQ), hasr = (i != SEQ - 1) && (i != TPB - 1);
        v4u gl, gc, gr, vv;
        if (s_ == 0) { gc = *(const v4u*)(SBG + ((size_t)B * 4 + 0) * DFF + col); gr = *(const v4u*)(SBG + ((size_t)B * 4 + 1) * DFF + col); gl = hasl ? *(const v4u*)(SBG + ((size_t)(B - 1) * 4 + 3) * DFF + col) : Z; vv = *(const v4u*)(SBV + ((size_t)B * 2 + 0) * DFF + col); }
        else { gc = *(const v4u*)(SBG + ((size_t)B * 4 + 3) * DFF + col); gl = *(const v4u*)(SBG + ((size_t)B * 4 + 2) * DFF + col); gr = hasr ? *(const v4u*)(SBG + ((size_t)(B + 1) * 4 + 0) * DFF + col) : Z; vv = *(const v4u*)(SBV + ((size_t)B * 2 + 1) * DFF + col); }
        float fl[8], fc[8], fr[8], fv[8], o[8]; unpack8(gl, fl); unpack8(gc, fc); unpack8(gr, fr); unpack8(vv, fv);
        const f32x4 w0a = *(const f32x4*)(cw + col), w0b = *(const f32x4*)(cw + col + 4), w1a = *(const f32x4*)(cw + DFF + col), w1b = *(const f32x4*)(cw + DFF + col + 4);
        const f32x4 w2a = *(const f32x4*)(cw + 2 * DFF + col), w2b = *(const f32x4*)(cw + 2 * DFF + col + 4), ba = *(const f32x4*)(cb + col), bb = *(const f32x4*)(cb + col + 4);
        const float w0[8] = {w0a.x, w0a.y, w0a.z, w0a.w, w0b.x, w0b.y, w0b.z, w0b.w}, w1[8] = {w1a.x, w1a.y, w1a.z, w1a.w, w1b.x, w1b.y, w1b.z, w1b.w};
        const float w2[8] = {w2a.x, w2a.y, w2a.z, w2a.w, w2b.x, w2b.y, w2b.z, w2b.w}, bs8[8] = {ba.x, ba.y, ba.z, ba.w, bb.x, bb.y, bb.z, bb.w};
#pragma unroll
        for (int e = 0; e < 8; ++e) { const float g = fl[e] * w0[e] + fc[e] * w1[e] + fr[e] * w2[e] + bs8[e]; o[e] = g * __builtin_amdgcn_rcpf(1.0f + __expf(-g)) * fv[e]; }
        *(v4u*)(A + (size_t)r * DFF + col) = pack8(o);
    }
}
__device__ __forceinline__ void attn_phase(const Frame& F0, int l) {
    const Frame F = fresh(F0);
    unsigned char* ws0 = ws_ptr(F); const float* rpb_in = in_ptr(F, I_RPB);
    bf16* P = (bf16*)(ws0 + WS_P); const unsigned char* KM8 = ws0 + WS_KM8; const unsigned char* VM8 = ws0 + WS_VM8; const unsigned char* VN8 = ws0 + WS_VN8; const unsigned char* VG8 = ws0 + WS_VG8; const unsigned char* KRR8 = ws0 + WS_KRR; const unsigned char* KG8 = ws0 + WS_KG8; const unsigned char* KN8 = ws0 + WS_KN8;
    const bool with_ctx = (l < DEPTH - 1);
    LAS char* lds = (LAS char*)F.lds;
    { const int nu = 1024 + (with_ctx ? 128 : 0);
      auto mk = [&](int u) -> att::AttnUnit {
        att::AttnUnit U; int b, h, row0;
        if (u < 1024) { b = u >> 7; h = (u >> 3) & 15; row0 = b * TPB + (u & 7) * 256; U.NT = 36; U.n0 = 36; U.base0 = b * TPB; U.base1 = 0; }
        else { const int v = u - 1024; b = v >> 4; h = v & 15; row0 = b * TPB + SEQ; U.NT = 4; U.n0 = 4; U.base0 = b * TPB + SEQ; U.base1 = 0; }
        U.Q = P + (size_t)row0 * LDP + C_MQ + h * 192; U.ldq = LDP;
        U.Kn = nullptr; U.ldkv = 2048; U.Kr = nullptr; U.ldkr = 0; U.V = nullptr; U.K8 = KM8 + h * 128; U.ldk8 = 2048; U.Kr8 = KRR8; U.V8 = VM8 + h * 128; U.ldv8 = 2048;
        U.O = P + (size_t)row0 * LDP + C_YA + h * 128; U.ldo = LDP; U.rpb = nullptr; U.qrow0 = 0; U.krow0 = 0;
        return U; };
      bool pre = false;
      for (int u = F.vcu; u < nu; u += F.G) { const bool hn = (u + F.G) < nu; const att::AttnUnit U = mk(u), N = mk(hn ? u + F.G : u);
        att::attn_body<192, 0, 1>(U, lds, N, hn, pre); pre = hn; }
      }
    { const int nu = 1024 + (with_ctx ? 256 : 0);
      auto mk = [&](int u) -> att::AttnUnit {
        att::AttnUnit U; int b, h, row0; int cq, cv; bool gqa = true;
        if (u < 1024) { b = u >> 7; h = (u >> 3) & 15; row0 = b * TPB + (u & 7) * 256; U.NT = 36; U.n0 = 36; U.base0 = b * TPB; }
        else { const int v = (u - 1024) & 127; b = v >> 4; h = v & 15; row0 = b * TPB + SEQ; U.NT = 4; U.n0 = 4; U.base0 = b * TPB + SEQ; gqa = (u < 1152); }
        if (gqa) { cq = C_GQ + h * 128; cv = C_GV + (h >> 2) * 128; U.K8 = KG8 + (h >> 2) * 128; U.ldk8 = 512; U.V8 = VG8 + (h >> 2) * 128; U.ldv8 = 512; } else { cq = C_NQ + h * 128; cv = C_NV + h * 128; U.K8 = KN8 + h * 128; U.ldk8 = 2048; U.V8 = VN8 + h * 128; U.ldv8 = 2048; }
        U.base1 = 0;
        U.Q = P + (size_t)row0 * LDP + cq; U.ldq = LDP; U.Kn = nullptr; U.ldkv = LDP; U.Kr = nullptr; U.ldkr = 0; U.V = P + cv;
        U.O = P + (size_t)row0 * LDP + cq; U.ldo = LDP; U.rpb = nullptr; U.qrow0 = 0; U.krow0 = 0; U.Kr8 = nullptr;
        return U; };
      bool pre = false;
      for (int u = F.vcu; u < nu; u += F.G) { const bool hn = (u + F.G) < nu; const att::AttnUnit U = mk(u), N = mk(hn ? u + F.G : u);
        att::attn_body<128, 0, 1, 1>(U, lds, N, hn, pre); pre = hn; }
      }
    { auto mk = [&](int u) -> att::AttnUnit {
        att::AttnUnit U; const int b = u >> 7, h = (u >> 3) & 15, qb = u & 7, row0 = b * TPB + qb * 256;
        int lo = 4 * qb - 4; lo = lo < 0 ? 0 : (lo > 24 ? 24 : lo); if (qb == 6) lo = 20;
        const int nlat = (qb == 0 || qb == 7) ? 8 : 12;
        U.NT = 4 + nlat; U.n0 = 4; U.base0 = b * TPB + SEQ; U.base1 = b * TPB + lo * 64; U.qrow0 = 4 * qb; U.krow0 = lo;
        U.Q = P + (size_t)row0 * LDP + C_NQ + h * 128; U.ldq = LDP; U.Kn = nullptr; U.ldkv = LDP; U.Kr = nullptr; U.ldkr = 0; U.V = P + C_NV + h * 128; U.K8 = KN8 + h * 128; U.ldk8 = 2048; U.Kr8 = nullptr; U.V8 = VN8 + h * 128; U.ldv8 = 2048;
        U.O = P + (size_t)row0 * LDP + C_NQ + h * 128; U.ldo = LDP; U.rpb = rpb_in + (size_t)(l * 16 + h) * 15 * 31;
        return U; };
      bool pre = false;
      for (int u = F.vcu; u < 1024; u += F.G) { const bool hn = (u + F.G) < 1024; const att::AttnUnit U = mk(u), N = mk(hn ? u + F.G : u);
        att::attn_body<128, 1, 1, 1>(U, lds, N, hn, pre); pre = hn; }
      }
}

template <int L>
__device__ __forceinline__ void layer_body(const Frame& F0) {
    constexpr int l = L;
    volatile LAS unsigned* MISC = (volatile LAS unsigned*)(F0.lds + MISC_OFF);
#define GRID_BAR() do { const Frame Fb_ = fresh(F0); volatile LAS unsigned* M_ = (volatile LAS unsigned*)(Fb_.lds + MISC_OFF); XcdBarrier b_; b_.bar = (unsigned*)(ws_ptr(Fb_) + WS_CTL) + CW_BAR; b_.x = (unsigned)__builtin_amdgcn_readfirstlane(M_[10]); b_.st = M_ + 8; xcd_barrier(b_); } while (0)
    {
        constexpr bool last = (l == DEPTH - 1);
        { const Frame F = fresh(F0); unsigned char* ws = ws_ptr(F); const int bx = opq_s(blockIdx.x), Gs = F.G; pg8::Gemm g{(const bf16*)(ws + WS_P) + C_YA, (const bf16*)(ws + WS_WIN), LDP, D / 2, 128}; pg8::StaticOrder S; if (!last) S.init(M / 256, NP / 256, Gs, bx, 0, 1); else S.init(64, NP / 256, Gs, bx, 1, 1, 8);
          pg8::EpiWin E{(bf16*)(ws + WS_P), LDP, 1.0f / W8_SCALE, ws, (unsigned char*)(ws + WS_KN8), (unsigned char*)(ws + WS_VN8), (unsigned char*)(ws + WS_VG8), C_NK, C_NV, C_GQ, C_GV, C_GATE, C_NQ};
          pg8::gemm_phase<pg8::EpiWin, true, true, true>(F.lds, g, S, E); }
        GRID_BAR();
        prep_phase(F0, l);
        GRID_BAR();
        { const Frame F = fresh(F0); unsigned char* ws = ws_ptr(F); const int bx = opq_s(blockIdx.x), Gs = F.G; pg8::Gemm g{(const bf16*)(ws + WS_C), (const bf16*)(ws + WS_WUKV), KVR / 2, KVR / 2, 128}; pg8::StaticOrder S; S.init(M / 256, KVW / 256, Gs, bx, 0, 1);
          pg8::EpiKV E{(unsigned char*)(ws + WS_KM8), (unsigned char*)(ws + WS_VM8), 1.0f / WKV_SCALE};
          pg8::gemm_phase<pg8::EpiKV, true, true, true>(F.lds, g, S, E); }
        GRID_BAR();
        attn_phase(F0, l);
        GRID_BAR();
        { const Frame F = fresh(F0); unsigned char* ws = ws_ptr(F); const int bx = opq_s(blockIdx.x), Gs = F.G; pg8::Gemm g{(const bf16*)(ws + WS_P), (const bf16*)(ws + WS_WBR), LDP, D / 2, 256}; pg8::StaticOrder S; S.init(last ? 64 : 72, D / 256, Gs, bx, last ? 1 : 0, 3);
          pg8::EpiMerge E{(bf16*)(ws + WS_ACC), D, (const bf16*)(ws + WS_P) + C_GATE, LDP, C_YA, C_NQ, C_GQ, 1.0f / (WB_SCALE * att::YS), (unsigned char*)(ws + WS_ACC8), ACC_SCALE};
          pg8::gemm_phase<pg8::EpiMerge, true, true, true>(F.lds, g, S, E); }
        GRID_BAR();
        { const Frame F = fresh(F0); unsigned char* ws = ws_ptr(F); const int bx = opq_s(blockIdx.x), Gs = F.G; pg8::Gemm g{(const bf16*)(ws + WS_ACC8), (const bf16*)(ws + WS_WOUT), D / 2, D / 2, 128}; pg8::StaticOrder S; S.init(last ? 64 : 72, D / 256, Gs, bx, last ? 1 : 0, 1);
          pg8::EpiBf16 E{(bf16*)(ws + WS_YOUT), D, 1.0f / (WB_SCALE * ACC_SCALE)};
          pg8::gemm_phase<pg8::EpiBf16, true, true, true>(F.lds, g, S, E); }
        GRID_BAR();
        row_phase<1>(F0, l, false);
        GRID_BAR();
        { const Frame F = fresh(F0); unsigned char* ws = ws_ptr(F); const int bx = opq_s(blockIdx.x), Gs = F.G; pg8::Gemm g{(const bf16*)(ws + WS_H2), (const bf16*)(ws + WS_WUP), D, D, 128}; pg8::StaticOrder S; S.init(last ? 64 : 72, DFF2 / 256, Gs, bx, last ? 1 : 0, 1);
          pg8::EpiConv E{(bf16*)(ws + WS_A), DFF, in_ptr(F, I_CONVW) + (size_t)l * 3 * DFF, in_ptr(F, I_CONVB) + (size_t)l * DFF, (bf16*)(ws + WS_SBG), (bf16*)(ws + WS_SBV)};
          pg8::gemm_phase<pg8::EpiConv, true, true>(F.lds, g, S, E); }
        GRID_BAR();
        conv_fixup(F0, l);
        GRID_BAR();
        { const Frame F = fresh(F0); unsigned char* ws = ws_ptr(F); const int bx = opq_s(blockIdx.x), Gs = F.G; pg8::Gemm g{(const bf16*)(ws + WS_A), (const bf16*)(ws + WS_WDN), DFF, DFF, 128}; pg8::StaticOrder S; S.init(last ? 64 : 72, D / 256, Gs, bx, last ? 1 : 0, 1);
          pg8::EpiBf16 E{(bf16*)(ws + WS_FOUT), D, 1.0f};
          pg8::gemm_phase<pg8::EpiBf16, true, true>(F.lds, g, S, E); }
        GRID_BAR();
        { const Frame F = fresh(F0); const bool poison = last && (xb_ld((unsigned*)(ws_ptr(F) + WS_CTL) + CW_BAR + XB_TMO) != 0u);
          row_phase<2>(F0, l, poison); }
        if (!last) { convert_weights(F0, l + 1); GRID_BAR(); }
    }
}

__global__ void __launch_bounds__(NWAVES * 64, 2) fwd_kernel(Args a) {
    extern __shared__ __attribute__((aligned(16))) unsigned char lds_raw[];
    Frame F;
    F.lds = (LAS unsigned char*)lds_raw;
    F.tid = threadIdx.x; F.lane = F.tid & 63; F.wave = __builtin_amdgcn_readfirstlane(F.tid >> 6);
    F.G = gridDim.x; { const int bx = blockIdx.x; F.vcu = (F.G % 8 == 0) ? (bx % 8) * (F.G / 8) + bx / 8 : bx; }
    volatile LAS unsigned* MISC = (volatile LAS unsigned*)(F.lds + MISC_OFF);
    for (int u = F.tid; u < (LDS_BYTES - LDSCTL_OFF) / 4; u += NWAVES * 64) ((LAS unsigned*)(F.lds + LDSCTL_OFF))[u] = 0u;
    __syncthreads();
    if (F.tid == 0) { LAS unsigned long long* pt = (LAS unsigned long long*)(F.lds + PTAB_OFF);
#pragma unroll
        for (int i = 0; i < 22; ++i) pt[i] = (unsigned long long)a.in[i];
        pt[22] = (unsigned long long)a.out; pt[23] = (unsigned long long)a.ws; }
    __syncthreads();
    { XcdBarrier b0 = xcd_barrier_post((unsigned*)(ws_ptr(F) + WS_CTL) + CW_BAR, MISC + 8); if (F.tid == 0) MISC[10] = b0.x; }
    __syncthreads();

    { const Frame& F0 = F;
    adaln_partial(F);
    convert_weights(F, 0);
    GRID_BAR();
    adaln_final(F);
    GRID_BAR();
    row_phase<0>(F, 0, false);
    GRID_BAR(); }

    layer_body<0>(F);
    layer_body<1>(F);
}

extern "C" void kernel_launch(void* const* d_in, const int* in_sizes, int n_in, void* d_out, int out_size, void* d_ws, size_t ws_size, hipStream_t stream) {
    static int grid = 0;
    if (grid == 0) {
        if (n_in != 22 || out_size != NB * SEQ * D || ws_size < WS_END) { fprintf(stderr, "kernel_launch: shape/workspace mismatch (n_in %d out %d ws %zu need %zu)\n", n_in, out_size, ws_size, (size_t)WS_END); grid = -1; return; }
        int dev = 0, cus = 0, per_cu = 0;
        if (hipGetDevice(&dev) != hipSuccess || hipDeviceGetAttribute(&cus, hipDeviceAttributeMultiprocessorCount, dev) != hipSuccess) { grid = -1; return; }
        if (hipFuncSetAttribute((const void*)fwd_kernel, hipFuncAttributeMaxDynamicSharedMemorySize, LDS_BYTES) != hipSuccess) { grid = -1; return; }
        if (hipOccupancyMaxActiveBlocksPerMultiprocessor(&per_cu, (const void*)fwd_kernel, NWAVES * 64, LDS_BYTES) != hipSuccess || per_cu < 1) fprintf(stderr, "kernel_launch: occupancy query reports %d\n", per_cu);
        (void)hipGetLastError();
        grid = cus;
    }
    if (grid < 0) return;
    if (hipMemsetAsync((char*)d_ws + WS_CTL, 0, CTL_ZERO_BYTES, stream) != hipSuccess) return;
    Args a{};
    for (int i = 0; i < 22; ++i) a.in[i] = (const float*)d_in[i];
    a.out = (float*)d_out; a.ws = (unsigned char*)d_ws;
    hipLaunchKernelGGL(fwd_kernel, dim3(grid), dim3(NWAVES * 64), LDS_BYTES, stream, a);
    const hipError_t le = hipPeekAtLastError();
    if (le != hipSuccess) fprintf(stderr, "kernel_launch: launch failed: %s\n", hipGetErrorName(le));
}
```
